# Optimizing an MI355X kernel written in HIP

```python
import jax, jax.numpy as jnp
from jax import lax
import numpy as np

D_MODEL = 1024
BATCH = 1
SEQ = 16384
DEPTH = 2
DEC_BATCH = 32
DEC_SEQ = 4
PAST_LEN = 16384
PAGE_SIZE = 128

N_EVEN = (DEPTH + 1) // 2
N_ODD = DEPTH // 2
ALPHA = (2.0 * DEPTH) ** 0.25
BETA = (8.0 * DEPTH) ** -0.25
LN_EPS = 1e-5

A_WIDTH = D_MODEL // 2
CONV_W = 31

B_WIDTH = D_MODEL // 2
B_HEAD = 64
B_HEADS = B_WIDTH // B_HEAD
DECAY_LORA = 32
A_LORA = 32
LNX_EPS = 64e-5

C_HEAD = 64
C_HEADS = D_MODEL // 128
C_GROUPS = ((128, 1), (512, 4), (2048, 16))
N_G = len(C_GROUPS)
C_GW = C_HEADS * C_HEAD

EVEN_SHIFT = 3 * B_WIDTH + DECAY_LORA + A_LORA
EVEN_COLS = EVEN_SHIFT + 3 * A_WIDTH + B_WIDTH
EVEN_SHIFT_SPLITS = [B_WIDTH, 2 * B_WIDTH, 3 * B_WIDTH, 3 * B_WIDTH + DECAY_LORA]
EVEN_REST_SPLITS = [A_WIDTH, 2 * A_WIDTH, 3 * A_WIDTH]
ODD_COLS = 3 * N_G * C_GW + C_GW
ODD_SPLITS = [N_G * C_GW, 2 * N_G * C_GW, 3 * N_G * C_GW]

kernel_name = 'hybrid_conformer_rwkv7_dilated_attn_decoder_step'


def layer_norm(x, g, b, eps=LN_EPS):
    xf = x.astype(jnp.float32)
    mu = xf.mean(-1, keepdims=True)
    var = jnp.square(xf - mu).mean(-1, keepdims=True)
    return ((xf - mu) * lax.rsqrt(var + eps) * g + b).astype(x.dtype)


def wkv_step(S, inp):
    r, w, k, v, kk, a = inp
    sa = jnp.einsum('bhij,bhj->bhi', S, -kk)
    S = S * w[:, :, None, :] + sa[..., :, None] * (kk * a)[..., None, :] + v[..., :, None] * k[..., None, :]
    return S, jnp.einsum('bhij,bhj->bhi', S, r)


def even_mixer(x, conv_buf, shift_prev, wkv, w_in, conv_w, conv_b, cln_g, cln_b, mu, w0, w2, a0, a2,
               k_k, k_a, r_k, lnx_g, lnx_b, w_out):
    Bn, T, _ = x.shape
    f32 = jnp.float32
    p = x @ w_in
    p_sh, p_rest = p[..., :EVEN_SHIFT], p[..., EVEN_SHIFT:]
    p0 = shift_prev.astype(x.dtype) @ w_in[:, :EVEN_SHIFT]
    p_prev = jnp.concatenate([p0[:, None], p_sh[:, :-1]], axis=1)
    p_sh = p_sh + (p_prev - p_sh) * mu
    r, k, v, wd, ad = jnp.split(p_sh, EVEN_SHIFT_SPLITS, axis=-1)
    a_val, a_glu, a_gate, b_gate = jnp.split(p_rest, EVEN_REST_SPLITS, axis=-1)

    u = a_val * jax.nn.sigmoid(a_glu)
    u_ext = jnp.concatenate([conv_buf.astype(u.dtype), u], axis=1)
    c = lax.conv_general_dilated(u_ext, conv_w[:, None, :].astype(u.dtype), window_strides=(1,),
                                 padding='VALID', dimension_numbers=('NWC', 'WIO', 'NWC'),
                                 feature_group_count=A_WIDTH) + conv_b
    new_conv = u_ext[:, -(CONV_W - 1):]
    y_a = jax.nn.silu(layer_norm(c, cln_g, cln_b)) * jax.nn.silu(a_gate)

    heads = lambda z: z.astype(f32).reshape(Bn, T, B_HEADS, B_HEAD)
    w_log = -jax.nn.softplus(-(w0 + jnp.tanh(wd) @ w2).astype(f32)) - 0.5
    decay = jnp.exp(-jnp.exp(w_log))
    a = jax.nn.sigmoid((a0 + ad @ a2).astype(f32))
    kk = heads(k * k_k)
    kk = kk / jnp.maximum(jnp.sqrt(jnp.sum(kk * kk, -1, keepdims=True)), 1e-12)
    k_mod = k.astype(f32) * (1.0 + (a - 1.0) * k_a)
    rh, wh, kh, vh, ah = heads(r), heads(decay), heads(k_mod), heads(v), heads(a)
    xs = tuple(jnp.moveaxis(z, 1, 0) for z in (rh, wh, kh, vh, kk, ah))
    S_final, o = lax.scan(wkv_step, wkv.astype(f32), xs)
    o = jnp.moveaxis(o, 0, 1)
    om = o.mean(-1, keepdims=True)
    ov = jnp.square(o - om).mean(-1, keepdims=True)
    o = ((o - om) * lax.rsqrt(ov + LNX_EPS)).reshape(Bn, T, B_WIDTH) * lnx_g + lnx_b
    bonus = (jnp.sum(rh * kh * r_k, -1, keepdims=True) * vh).reshape(Bn, T, B_WIDTH)
    y_b = ((o + bonus) * jax.nn.silu(b_gate.astype(f32))).astype(x.dtype)

    y = jnp.concatenate([y_a, y_b], axis=-1) @ w_out
    return y, new_conv, x[:, -1], S_final


def band_dilated_attention(q, k, v, window, dil):
    Bn, T, H, hd = q.shape
    span = window // dil
    L = T // dil
    nb = -(-L // span)
    Lp = nb * span

    def classes(z):
        z = z.reshape(Bn, L, dil, H, hd).transpose(0, 2, 1, 3, 4).reshape(Bn * dil, L, H, hd)
        z = jnp.pad(z, ((0, 0), (0, Lp - L), (0, 0), (0, 0)))
        return z.reshape(Bn * dil, nb, span, H, hd)

    def band(z):
        prev = jnp.pad(z[:, :-1], ((0, 0), (1, 0), (0, 0), (0, 0), (0, 0)))
        return jnp.concatenate([prev, z], axis=2)

    qb = classes(q)
    kb, vb = band(classes(k)), band(classes(v))
    s = jnp.einsum('nbqhd,nbkhd->nbhqk', qb, kb).astype(jnp.float32) * (hd ** -0.5)
    qi = np.arange(span)[:, None]
    ki = np.arange(2 * span)[None, :]
    in_band = (ki >= qi) & (ki <= qi + span)
    mask = np.where(np.arange(nb)[:, None, None] == 0, in_band & (ki >= span), in_band)
    s = jnp.where(mask[None, :, None], s, -jnp.inf)
    lse = jax.nn.logsumexp(s, axis=-1)
    pr = jnp.exp(s - lse[..., None])
    o = jnp.einsum('nbhqk,nbkhd->nbqhd', pr, vb.astype(jnp.float32))
    o = o.reshape(Bn, dil, Lp, H, hd)[:, :, :L].transpose(0, 2, 1, 3, 4).reshape(Bn, T, H, hd)
    lse = lse.transpose(0, 1, 3, 2).reshape(Bn, dil, Lp, H)[:, :, :L].transpose(0, 2, 1, 3).reshape(Bn, T, H)
    return o, lse


def gathered_dilated_attention(q, kv_ext, window, dil, n_buf):
    S, hd = q.shape[1], q.shape[-1]
    span = window // dil
    idx = n_buf + np.arange(S)[:, None] - dil * np.arange(span + 1)[None, :]
    valid = idx >= 0
    g = kv_ext[:, np.maximum(idx, 0)]
    s = jnp.einsum('bshd,bsjhd->bshj', q, g[:, :, :, 0]).astype(jnp.float32) * (hd ** -0.5)
    s = jnp.where(valid[None, :, None, :], s, -jnp.inf)
    lse = jax.nn.logsumexp(s, axis=-1)
    pr = jnp.exp(s - lse[..., None])
    o = jnp.einsum('bshj,bsjhd->bshd', pr, g[:, :, :, 1].astype(jnp.float32))
    return o, lse


def odd_mixer(x, bufs, w_in, w_out):
    Bn, T, _ = x.shape
    p = x @ w_in
    q, k, v, gate = jnp.split(p, ODD_SPLITS, axis=-1)
    q = q.reshape(Bn, T, N_G, C_HEADS, C_HEAD)
    k = k.reshape(Bn, T, N_G, C_HEADS, C_HEAD)
    v = v.reshape(Bn, T, N_G, C_HEADS, C_HEAD)
    outs, lses, new = [], [], []
    for gi, (win, dil) in enumerate(C_GROUPS):
        kv = jnp.stack([k[:, :, gi], v[:, :, gi]], axis=2)
        if bufs is None:
            o, lse = band_dilated_attention(q[:, :, gi], k[:, :, gi], v[:, :, gi], win, dil)
            new.append(kv[:, -min(win, T):])
        else:
            buf = bufs[gi].astype(kv.dtype)
            n_buf = buf.shape[1]
            ext = jnp.concatenate([buf, kv], axis=1)
            o, lse = gathered_dilated_attention(q[:, :, gi], ext, win, dil, n_buf)
            new.append(ext[:, -n_buf:])
        outs.append(o)
        lses.append(lse)
    wts = jax.nn.softmax(jnp.stack(lses, 0), axis=0)
    o = jnp.einsum('gbth,gbthd->bthd', wts, jnp.stack(outs, 0))
    y = (o.reshape(Bn, T, C_GW) * jax.nn.silu(gate.astype(jnp.float32))).astype(x.dtype) @ w_out
    return y, new


def setup_inputs(seed: int = 0) -> dict:
    key = jax.random.key(seed)
    ks = iter(jax.random.split(key, 40))
    nrm = lambda shape, scale=1.0: scale * jax.random.normal(next(ks), shape, jnp.float32)
    lb = [min(w, PAST_LEN) for w, _ in C_GROUPS]
    return {
        'x_prompt': nrm((BATCH, SEQ, D_MODEL)),
        'x_sample': nrm((DEC_BATCH, DEC_SEQ, D_MODEL)),
        'state_conv': nrm((N_EVEN, DEC_BATCH, CONV_W - 1, A_WIDTH), 0.5),
        'state_shift': nrm((N_EVEN, DEC_BATCH, D_MODEL)),
        'state_wkv': nrm((N_EVEN, DEC_BATCH, B_HEADS, B_HEAD, B_HEAD), 0.3),
        'cache_kv_w128': nrm((N_ODD, DEC_BATCH, lb[0], 2, C_HEADS, C_HEAD)),
        'cache_kv_w512': nrm((N_ODD, DEC_BATCH, lb[1], 2, C_HEADS, C_HEAD)),
        'cache_kv_w2048': nrm((N_ODD, DEC_BATCH, lb[2], 2, C_HEADS, C_HEAD)),
        'w_in_even': nrm((N_EVEN, D_MODEL, EVEN_COLS), D_MODEL ** -0.5),
        'conv_w': nrm((N_EVEN, CONV_W, A_WIDTH), CONV_W ** -0.5),
        'conv_b': nrm((N_EVEN, A_WIDTH), 0.02),
        'conv_ln_g': 1.0 + nrm((N_EVEN, A_WIDTH), 0.05),
        'conv_ln_b': nrm((N_EVEN, A_WIDTH), 0.02),
        'mu_shift': jax.random.uniform(next(ks), (N_EVEN, EVEN_SHIFT), jnp.float32),
        'w0': jnp.linspace(-6.0, -1.0, B_WIDTH, dtype=jnp.float32) + nrm((N_EVEN, B_WIDTH), 0.1),
        'w2': nrm((N_EVEN, DECAY_LORA, B_WIDTH), 0.1 * DECAY_LORA ** -0.5),
        'a0': nrm((N_EVEN, B_WIDTH), 0.1),
        'a2': nrm((N_EVEN, A_LORA, B_WIDTH), 0.5 * A_LORA ** -0.5),
        'k_k': 0.85 + nrm((N_EVEN, B_WIDTH), 0.05),
        'k_a': 1.0 + nrm((N_EVEN, B_WIDTH), 0.05),
        'r_k': nrm((N_EVEN, B_HEADS, B_HEAD), 0.1),
        'lnx_g': 1.0 + nrm((N_EVEN, B_WIDTH), 0.05),
        'lnx_b': nrm((N_EVEN, B_WIDTH), 0.02),
        'w_out_even': nrm((N_EVEN, A_WIDTH + B_WIDTH, D_MODEL), BETA * (A_WIDTH + B_WIDTH) ** -0.5),
        'w_in_odd': nrm((N_ODD, D_MODEL, ODD_COLS), D_MODEL ** -0.5),
        'w_out_odd': nrm((N_ODD, C_GW, D_MODEL), BETA * C_GW ** -0.5),
        'ln_g': 1.0 + nrm((DEPTH, D_MODEL), 0.05),
        'ln_b': nrm((DEPTH, D_MODEL), 0.02),
    }


def reference(x_prompt, x_sample, state_conv, state_shift, state_wkv, cache_kv_w128, cache_kv_w512,
              cache_kv_w2048, w_in_even, conv_w, conv_b, conv_ln_g, conv_ln_b, mu_shift, w0, w2, a0, a2,
              k_k, k_a, r_k, lnx_g, lnx_b, w_out_even, w_in_odd, w_out_odd, ln_g, ln_b):
    xp, xs = x_prompt, x_sample
    nbp = xp.shape[0]
    caches = (cache_kv_w128, cache_kv_w512, cache_kv_w2048)
    conv_p, conv_s, shift_p, shift_s, wkv_p, wkv_s = [], [], [], [], [], []
    kv_p = [[] for _ in C_GROUPS]
    kv_s = [[] for _ in C_GROUPS]
    for l in range(DEPTH):
        i = l // 2
        if l % 2 == 0:
            ev = (w_in_even[i], conv_w[i], conv_b[i], conv_ln_g[i], conv_ln_b[i], mu_shift[i], w0[i], w2[i],
                  a0[i], a2[i], k_k[i], k_a[i], r_k[i], lnx_g[i], lnx_b[i], w_out_even[i])
            yp, cp, sp, wp = even_mixer(xp, jnp.zeros((nbp, CONV_W - 1, A_WIDTH), xp.dtype),
                                        jnp.zeros((nbp, D_MODEL), xp.dtype),
                                        jnp.zeros((nbp, B_HEADS, B_HEAD, B_HEAD), jnp.float32), *ev)
            ys, cs, ss, ws = even_mixer(xs, state_conv[i], state_shift[i], state_wkv[i], *ev)
            conv_p.append(cp); conv_s.append(cs)
            shift_p.append(sp); shift_s.append(ss)
            wkv_p.append(wp); wkv_s.append(ws)
        else:
            yp, newp = odd_mixer(xp, None, w_in_odd[i], w_out_odd[i])
            ys, news = odd_mixer(xs, tuple(c[i] for c in caches), w_in_odd[i], w_out_odd[i])
            for gi in range(N_G):
                kv_p[gi].append(newp[gi]); kv_s[gi].append(news[gi])
        xp = layer_norm(ALPHA * xp + yp, ln_g[l], ln_b[l])
        xs = layer_norm(ALPHA * xs + ys, ln_g[l], ln_b[l])
    return (xp, xs,
            jnp.stack(conv_p), jnp.stack(conv_s),
            jnp.stack(shift_p), jnp.stack(shift_s),
            jnp.stack(wkv_p), jnp.stack(wkv_s),
            jnp.stack(kv_p[0]), jnp.stack(kv_s[0]),
            jnp.stack(kv_p[1]), jnp.stack(kv_s[1]),
            jnp.stack(kv_p[2]), jnp.stack(kv_s[2]))
```

```cpp
#include <hip/hip_runtime.h>
#include <hip/hip_bf16.h>
#include <hip/hip_cooperative_groups.h>
#include <cstdio>
namespace cg = cooperative_groups;

#ifndef MEGA
#define MEGA 1
#endif
#ifndef REPMASK
#define REPMASK 0
#endif

typedef __attribute__((ext_vector_type(8))) short bf16x8;
typedef __attribute__((ext_vector_type(4))) float f32x4;
typedef unsigned short u16;
#define DEVI __device__ __forceinline__

constexpr int T = 16384;
constexpr int NS = 128;
constexpr int MT = T + NS;
constexpr int MX = MT + 32;
constexpr int MP = 16640;
constexpr int EC = 3648, ECP = 3712, OC = 5120;
constexpr float ALPHA = 1.41421356237f;
constexpr int SCAN_STRIDE = MT * 512;
constexpr int SMEM_BYTES = 61440;

struct Params {
  const float *x_prompt, *x_sample, *state_conv, *state_shift, *state_wkv, *cache0, *cache1, *cache2;
  const float *w_in_even, *conv_w, *conv_b, *cln_g, *cln_b, *mu, *w0, *w2, *a0, *a2, *k_k, *k_a, *r_k,
      *lnx_g, *lnx_b, *w_out_even, *w_in_odd, *w_out_odd, *ln_g, *ln_b;
  float *y_prompt, *y_sample, *conv_p, *conv_s, *shift_p, *shift_s, *wkv_p, *wkv_s, *kvp0, *kvs0, *kvp1, *kvs1,
      *kvp2, *kvs2;
  u16 *Xb, *WinE, *WoutE, *WinO, *WoutO, *Y, *X1b, *O2;
  float *Z, *X1, *P, *scan, *U, *Oraw, *AO, *LSE, *Gbuf, *Hbuf, *Sst;
  u16* QKVG;
  unsigned* bar;
};

DEVI u16 f2bf(float f) {
  unsigned u = __float_as_uint(f);
  u += 0x7fffu + ((u >> 16) & 1u);
  return (u16)(u >> 16);
}
template <int CTRL> DEVI float dppf(float x) {
  return __builtin_bit_cast(float, __builtin_amdgcn_mov_dpp(__builtin_bit_cast(int, x), CTRL, 0xf, 0xf, true));
}
DEVI float row16_sum(float x) {
  x += dppf<0x128>(x);
  x += dppf<0x124>(x);
  x += dppf<0x4E>(x);
  x += dppf<0xB1>(x);
  return x;
}
DEVI float row16_max(float x) {
  x = fmaxf(x, dppf<0x128>(x));
  x = fmaxf(x, dppf<0x124>(x));
  x = fmaxf(x, dppf<0x4E>(x));
  x = fmaxf(x, dppf<0xB1>(x));
  return x;
}
DEVI float wave_sum(float v) {
  v = row16_sum(v);
  v += __shfl_xor(v, 16);
  v += __shfl_xor(v, 32);
  return v;
}
DEVI float wave_max(float v) {
  v = row16_max(v);
  v = fmaxf(v, __shfl_xor(v, 16));
  v = fmaxf(v, __shfl_xor(v, 32));
  return v;
}
DEVI float frcp(float x) { return __builtin_amdgcn_rcpf(x); }
DEVI float sigmoidf_(float x) { return frcp(1.f + __expf(-x)); }
DEVI float siluf_(float x) { return x * frcp(1.f + __expf(-x)); }
DEVI int prev_row(int row) {
  if (row < T) return row - 1;
  int q = row - T;
  if (q & 3) return row - 1;
  return MT + (q >> 2);
}

__device__ void transpose_tile(const float* __restrict__ W, u16* __restrict__ Wt, int K, int N, int tk, int tn,
                               float* lds) {
  const int tid = threadIdx.x;
  const int k0 = tk * 64, n0 = tn * 64;
  __syncthreads();
  for (int e = tid; e < 4096; e += 256) {
    int kk = e >> 6, nn = e & 63;
    int n = n0 + nn;
    lds[kk * 65 + nn] = (n < N) ? W[(long)(k0 + kk) * N + n] : 0.f;
  }
  __syncthreads();
  for (int e = tid; e < 4096; e += 256) {
    int nn = e >> 6, kk = e & 63;
    Wt[(long)(n0 + nn) * K + k0 + kk] = f2bf(lds[kk * 65 + nn]);
  }
}

template <int W>
__device__ void copy_cache(const float* __restrict__ src, float* __restrict__ dst, int bid, int nb) {
  constexpr int per_b = (W - 4) * 256;
  constexpr int total = 32 * per_b;
  const float4* s4 = (const float4*)src;
  float4* d4 = (float4*)dst;
  const int stride = nb * 256;
  for (int i = bid * 256 + threadIdx.x; i < total; i += 4 * stride) {
    float4 v[4];
    int o[4];
#pragma unroll
    for (int k = 0; k < 4; ++k) {
      const int idx = i + k * stride;
      const int ii = min(idx, total - 1);
      const int b = ii / per_b, rem = ii - b * per_b;
      o[k] = idx < total ? b * (W * 256) + rem : -1;
      v[k] = s4[b * (W * 256) + rem + 1024];
    }
#pragma unroll
    for (int k = 0; k < 4; ++k)
      if (o[k] >= 0) d4[o[k]] = v[k];
  }
}

__device__ void phaseA(const Params& p, int bid, int nb, char* smem) {
  const int tid = threadIdx.x;
  {
    const long total = (long)MP * 256;
    for (long i = (long)bid * 256 + tid; i < total; i += (long)nb * 256) {
      int row = (int)(i >> 8), c4 = (int)(i & 255);
      float4 v = make_float4(0.f, 0.f, 0.f, 0.f);
      if (row < T) v = ((const float4*)p.x_prompt)[(long)row * 256 + c4];
      else if (row < MT) v = ((const float4*)p.x_sample)[(long)(row - T) * 256 + c4];
      else if (row < MX) v = ((const float4*)p.state_shift)[(long)(row - MT) * 256 + c4];
      ushort4 o;
      o.x = f2bf(v.x); o.y = f2bf(v.y); o.z = f2bf(v.z); o.w = f2bf(v.w);
      ((ushort4*)p.Xb)[i] = o;
    }
  }
  {
    const int n0 = 16 * 58, n1 = n0 + 16 * 16, n2 = n1 + 16 * 80, n3 = n2 + 8 * 16;
    for (int t = bid; t < n3; t += nb) {
      if (t < n0) transpose_tile(p.w_in_even, p.WinE, 1024, EC, t % 16, t / 16, (float*)smem);
      else if (t < n1) transpose_tile(p.w_out_even, p.WoutE, 1024, 1024, (t - n0) % 16, (t - n0) / 16, (float*)smem);
      else if (t < n2) transpose_tile(p.w_in_odd, p.WinO, 1024, OC, (t - n1) % 16, (t - n1) / 16, (float*)smem);
      else transpose_tile(p.w_out_odd, p.WoutO, 512, 1024, (t - n2) % 8, (t - n2) / 8, (float*)smem);
    }
  }
  for (int i = bid * 256 + tid; i < 30 * 512; i += nb * 256) p.U[i - 30 * 512] = 0.f;
  for (int i = bid * 256 + tid; i < 1024 + 32 * 1024; i += nb * 256) {
    if (i < 1024) p.shift_p[i] = p.x_prompt[(long)(T - 1) * 1024 + i];
    else {
      int q = i - 1024, b = q >> 10, c = q & 1023;
      p.shift_s[q] = p.x_sample[(long)(b * 4 + 3) * 1024 + c];
    }
  }
}

template <int EPI>
__device__ void gemm_phase(const u16* __restrict__ A, const u16* __restrict__ Bt, int K, int nM, int nN,
                           float* __restrict__ C, int ldc, const float* __restrict__ res0,
                           const float* __restrict__ res1, int bid, int nb, char* smem) {
  u16* sA = (u16*)smem;
  u16* sB = sA + 2 * 5120;
  const int tid = threadIdx.x, lane = tid & 63, w = tid >> 6, wm = w >> 1, wn = w & 1;
  const int lr = lane & 15, lq = lane >> 4;
  const int ntiles = nM * nN, nk = K / 32;
  const int r0 = tid >> 2, kc = tid & 3;
  const int so0 = r0 * 40 + kc * 8, so1 = so0 + 64 * 40;
  for (int tile = bid; tile < ntiles; tile += nb) {
    int nig = 8 * nN, gid = tile / nig, fm = gid * 8, gsz = min(nM - fm, 8);
    int tm = fm + ((tile % nig) % gsz), tn = (tile % nig) / gsz;
    const u16* a0p = A + (long)(tm * 128 + r0) * K + kc * 8;
    const u16* a1p = a0p + 64L * K;
    const u16* b0p = Bt + (long)(tn * 128 + r0) * K + kc * 8;
    const u16* b1p = b0p + 64L * K;
    uint4 ea0 = *(const uint4*)a0p, ea1 = *(const uint4*)a1p, eb0 = *(const uint4*)b0p, eb1 = *(const uint4*)b1p;
    uint4 oa0 = *(const uint4*)(a0p + 32), oa1 = *(const uint4*)(a1p + 32), ob0 = *(const uint4*)(b0p + 32),
          ob1 = *(const uint4*)(b1p + 32);
    f32x4 acc[4][4];
#pragma unroll
    for (int mi = 0; mi < 4; ++mi)
#pragma unroll
      for (int ni = 0; ni < 4; ++ni) acc[mi][ni] = (f32x4){0.f, 0.f, 0.f, 0.f};
    __syncthreads();
    *(uint4*)&sA[so0] = ea0; *(uint4*)&sA[so1] = ea1; *(uint4*)&sB[so0] = eb0; *(uint4*)&sB[so1] = eb1;
    __syncthreads();
    auto compute = [&](int buf) {
      const u16* cA = sA + buf * 5120;
      const u16* cB = sB + buf * 5120;
      bf16x8 af[4], bfr[4];
#pragma unroll
      for (int mi = 0; mi < 4; ++mi) af[mi] = *(const bf16x8*)&cA[(wm * 64 + mi * 16 + lr) * 40 + lq * 8];
#pragma unroll
      for (int ni = 0; ni < 4; ++ni) bfr[ni] = *(const bf16x8*)&cB[(wn * 64 + ni * 16 + lr) * 40 + lq * 8];
#pragma unroll
      for (int mi = 0; mi < 4; ++mi)
#pragma unroll
        for (int ni = 0; ni < 4; ++ni)
          acc[mi][ni] = __builtin_amdgcn_mfma_f32_16x16x32_bf16(af[mi], bfr[ni], acc[mi][ni], 0, 0, 0);
    };
    for (int kt = 0; kt < nk; kt += 2) {
      {
        const int kn = min(kt + 2, nk - 1) * 32;
        ea0 = *(const uint4*)(a0p + kn); ea1 = *(const uint4*)(a1p + kn);
        eb0 = *(const uint4*)(b0p + kn); eb1 = *(const uint4*)(b1p + kn);
      }
      __builtin_amdgcn_sched_barrier(0);
      compute(0);
      __builtin_amdgcn_sched_barrier(0);
      *(uint4*)&sA[5120 + so0] = oa0; *(uint4*)&sA[5120 + so1] = oa1;
      *(uint4*)&sB[5120 + so0] = ob0; *(uint4*)&sB[5120 + so1] = ob1;
      __syncthreads();
      {
        const int kn = min(kt + 3, nk - 1) * 32;
        oa0 = *(const uint4*)(a0p + kn); oa1 = *(const uint4*)(a1p + kn);
        ob0 = *(const uint4*)(b0p + kn); ob1 = *(const uint4*)(b1p + kn);
      }
      __builtin_amdgcn_sched_barrier(0);
      compute(1);
      __builtin_amdgcn_sched_barrier(0);
      *(uint4*)&sA[so0] = ea0; *(uint4*)&sA[so1] = ea1; *(uint4*)&sB[so0] = eb0; *(uint4*)&sB[so1] = eb1;
      __syncthreads();
    }
#pragma unroll
    for (int mi = 0; mi < 4; ++mi) {
#pragma unroll
      for (int j = 0; j < 4; ++j) {
        const int row = tm * 128 + wm * 64 + mi * 16 + lq * 4 + j;
        const int col = tn * 128 + wn * 64 + lr;
        float* cp = C + (long)row * ldc + col;
        if (EPI == 2) {
          u16* cb = (u16*)C + (long)row * ldc + col;
          const float sc = (tn * 128 < 1536) ? 0.125f : 1.f;
#pragma unroll
          for (int ni = 0; ni < 4; ++ni) cb[ni * 16] = f2bf(acc[mi][ni][j] * sc);
        } else if (EPI == 1) {
          const float* rp = (row < T ? res0 + (long)row * 1024 : res1 + (long)(row - T) * 1024) + col;
#pragma unroll
          for (int ni = 0; ni < 4; ++ni) cp[ni * 16] = acc[mi][ni][j] + ALPHA * rp[ni * 16];
        } else {
#pragma unroll
          for (int ni = 0; ni < 4; ++ni) cp[ni * 16] = acc[mi][ni][j];
        }
      }
      asm volatile("" ::: "memory");
    }
  }
}

template <int EPI>
__device__ void gemm_big(const u16* __restrict__ A, const u16* __restrict__ Bt, int K, int nM, int nN,
                         float* __restrict__ C, int ldc, int bid, int nb, char* smem) {
  u16* sA = (u16*)smem;
  u16* sB = sA + 2 * 10240;
  const int tid = threadIdx.x, lane = tid & 63, w = tid >> 6, wm = w >> 1, wn = w & 1;
  const int lr = lane & 15, lq = lane >> 4;
  const int ntiles = nM * nN, nk = K / 32;
  const int r0 = tid >> 2, kc = tid & 3;
  const int so = r0 * 40 + kc * 8;
  for (int tile = bid; tile < ntiles; tile += nb) {
    int nig = 8 * nN, gid = tile / nig, fm = gid * 8, gsz = min(nM - fm, 8);
    int tm = fm + ((tile % nig) % gsz), tn = (tile % nig) / gsz;
    const u16* ap = A + (long)(tm * 256 + r0) * K + kc * 8;
    const u16* bp = Bt + (long)(tn * 128 + r0) * K + kc * 8;
    uint4 ra0 = *(const uint4*)ap, ra1 = *(const uint4*)(ap + 64L * K), ra2 = *(const uint4*)(ap + 128L * K),
          ra3 = *(const uint4*)(ap + 192L * K);
    uint4 rb0 = *(const uint4*)bp, rb1 = *(const uint4*)(bp + 64L * K);
    f32x4 acc[8][4];
#pragma unroll
    for (int mi = 0; mi < 8; ++mi)
#pragma unroll
      for (int ni = 0; ni < 4; ++ni) acc[mi][ni] = (f32x4){0.f, 0.f, 0.f, 0.f};
    __syncthreads();
    *(uint4*)&sA[so] = ra0; *(uint4*)&sA[so + 2560] = ra1; *(uint4*)&sA[so + 5120] = ra2; *(uint4*)&sA[so + 7680] = ra3;
    *(uint4*)&sB[so] = rb0; *(uint4*)&sB[so + 2560] = rb1;
    __syncthreads();
    for (int kt = 0; kt < nk; ++kt) {
      const int buf = kt & 1;
      {
        const int kn = min(kt + 1, nk - 1) * 32;
        ra0 = *(const uint4*)(ap + kn); ra1 = *(const uint4*)(ap + 64L * K + kn);
        ra2 = *(const uint4*)(ap + 128L * K + kn); ra3 = *(const uint4*)(ap + 192L * K + kn);
        rb0 = *(const uint4*)(bp + kn); rb1 = *(const uint4*)(bp + 64L * K + kn);
      }
      __builtin_amdgcn_sched_barrier(0);
      const u16* cA = sA + buf * 10240;
      const u16* cB = sB + buf * 5120;
      bf16x8 bfr[4];
#pragma unroll
      for (int ni = 0; ni < 4; ++ni) bfr[ni] = *(const bf16x8*)&cB[(wn * 64 + ni * 16 + lr) * 40 + lq * 8];
#pragma unroll
      for (int mi = 0; mi < 8; ++mi) {
        const bf16x8 af = *(const bf16x8*)&cA[(wm * 128 + mi * 16 + lr) * 40 + lq * 8];
#pragma unroll
        for (int ni = 0; ni < 4; ++ni)
          acc[mi][ni] = __builtin_amdgcn_mfma_f32_16x16x32_bf16(af, bfr[ni], acc[mi][ni], 0, 0, 0);
      }
      __builtin_amdgcn_sched_barrier(0);
      {
        u16* nA = sA + (buf ^ 1) * 10240;
        u16* nB = sB + (buf ^ 1) * 5120;
        *(uint4*)&nA[so] = ra0; *(uint4*)&nA[so + 2560] = ra1; *(uint4*)&nA[so + 5120] = ra2; *(uint4*)&nA[so + 7680] = ra3;
        *(uint4*)&nB[so] = rb0; *(uint4*)&nB[so + 2560] = rb1;
      }
      __syncthreads();
    }
#pragma unroll
    for (int mi = 0; mi < 8; ++mi) {
#pragma unroll
      for (int j = 0; j < 4; ++j) {
        const int row = tm * 256 + wm * 128 + mi * 16 + lq * 4 + j;
        const int col = tn * 128 + wn * 64 + lr;
        if (EPI == 2) {
          u16* cb = (u16*)C + (long)row * ldc + col;
          const float sc = (tn * 128 < 1536) ? 0.125f : 1.f;
#pragma unroll
          for (int ni = 0; ni < 4; ++ni) cb[ni * 16] = f2bf(acc[mi][ni][j] * sc);
        } else {
          float* cp = C + (long)row * ldc + col;
#pragma unroll
          for (int ni = 0; ni < 4; ++ni) cp[ni * 16] = acc[mi][ni][j];
        }
      }
      asm volatile("" ::: "memory");
    }
  }
}

__device__ void phaseC(const Params& p, int bid, int nb, char* smem) {
  float* lwd = (float*)smem;
  float* lad = lwd + 256;
  const int tid = threadIdx.x;
  const float* __restrict__ P = p.P;
#pragma unroll 1
  for (int half = 0; half < 2; ++half) {
    const int c = tid + half * 256;
    float w2c[32], a2c[32];
#pragma unroll
    for (int l = 0; l < 32; ++l) { w2c[l] = p.w2[l * 512 + c]; a2c[l] = p.a2[l * 512 + c]; }
    const float w0c = p.w0[c], a0c = p.a0[c];
    const float mur = p.mu[c], muk = p.mu[512 + c], muv = p.mu[1024 + c];
    const float kkc = p.k_k[c], kac = p.k_a[c];
    const float mwa = p.mu[1536 + (tid & 63)];
    for (int it = bid; it < MT / 8; it += nb) {
      const int row0 = it * 8;
      __syncthreads();
#pragma unroll
      for (int e = tid; e < 512; e += 256) {
        int r = e >> 6, cc = e & 63;
        int row = row0 + r, prow = prev_row(row);
        float cur = P[(long)row * ECP + 1536 + cc];
        float prv = prow >= 0 ? P[(long)prow * ECP + 1536 + cc] : 0.f;
        float val = cur + (prv - cur) * mwa;
        if (cc < 32) lwd[r * 32 + cc] = 1.f - 2.f * frcp(1.f + __expf(2.f * val));
        else lad[r * 32 + cc - 32] = val;
      }
      __syncthreads();
#pragma unroll 2
      for (int r = 0; r < 8; ++r) {
        const int row = row0 + r, prow = prev_row(row);
        const float* pc = P + (long)row * ECP;
        const float cr = pc[c], ck = pc[512 + c], cv = pc[1024 + c], cval = pc[1600 + c], cglu = pc[2112 + c];
        float pr = 0.f, pk = 0.f, pv = 0.f;
        if (prow >= 0) { const float* pp = P + (long)prow * ECP; pr = pp[c]; pk = pp[512 + c]; pv = pp[1024 + c]; }
        float aw = w0c, aa = a0c;
#pragma unroll
        for (int l4 = 0; l4 < 8; ++l4) {
          const float4 x = *(const float4*)&lwd[r * 32 + l4 * 4];
          const float4 y = *(const float4*)&lad[r * 32 + l4 * 4];
          aw += x.x * w2c[l4 * 4] + x.y * w2c[l4 * 4 + 1] + x.z * w2c[l4 * 4 + 2] + x.w * w2c[l4 * 4 + 3];
          aa += y.x * a2c[l4 * 4] + y.y * a2c[l4 * 4 + 1] + y.z * a2c[l4 * 4 + 2] + y.w * a2c[l4 * 4 + 3];
        }
        float rr = cr + (pr - cr) * mur, kx = ck + (pk - ck) * muk, vv = cv + (pv - cv) * muv;
        float z = -aw;
        float sp = fmaxf(z, 0.f) + __logf(1.f + __expf(-fabsf(z)));
        float decay = __expf(-__expf(-sp - 0.5f));
        float a = sigmoidf_(aa);
        float kkv = kx * kkc;
        float ss = wave_sum(kkv * kkv);
        kkv = kkv * fminf(__builtin_amdgcn_rsqf(ss), 1e12f);
        float kmod = kx * (1.f + (a - 1.f) * kac);
        float* so = p.scan + (long)row * 3072 + c;
        so[0] = rr;
        so[512] = decay;
        so[1024] = kmod;
        so[1536] = vv;
        so[2048] = kkv;
        so[2560] = -(kkv * a);
        p.U[(long)row * 512 + c] = cval * sigmoidf_(cglu);
      }
    }
  }
}

typedef float f2 __attribute__((ext_vector_type(2)));
constexpr int CH = 128;
constexpr int NCH = T / CH;
DEVI float row8_sum(float x) {
  x += dppf<0x141>(x);
  x += dppf<0x4E>(x);
  x += dppf<0xB1>(x);
  return x;
}
template <int R, bool P1>
__device__ void scan_chunk(const Params& p, int h, int row0, int nsteps, const float* __restrict__ init,
                           float* __restrict__ fin0, float* __restrict__ fin1, char* smem) {
  constexpr bool OUT = !P1;
  float* buf = (float*)smem;
  const int tid = threadIdx.x, lane = tid & 63, w = tid >> 6, cg = lane & 7, rg = lane >> 3;
  const int rowb = w * 8 * R + rg * R, j0 = cg * 8;
  const bool isG = P1 && (rowb >= 64);
  const int ib = rowb & 63;
  f2 S[R][4];
#pragma unroll
  for (int rr = 0; rr < R; ++rr) {
    if (!P1) {
      float4 t0 = *(const float4*)(init + (ib + rr) * 64 + j0), t1 = *(const float4*)(init + (ib + rr) * 64 + j0 + 4);
      S[rr][0] = (f2){t0.x, t0.y}; S[rr][1] = (f2){t0.z, t0.w};
      S[rr][2] = (f2){t1.x, t1.y}; S[rr][3] = (f2){t1.z, t1.w};
    } else {
      int d = isG ? ib + rr - j0 : -1;
#pragma unroll
      for (int q = 0; q < 4; ++q) S[rr][q] = (f2){d == 2 * q ? 1.f : 0.f, d == 2 * q + 1 ? 1.f : 0.f};
    }
  }
  const int nch = (nsteps + 15) >> 4;
  const float* __restrict__ sc = p.scan;
  float4 pre[6];
  __syncthreads();
#pragma unroll
  for (int q = 0; q < 6; ++q) {
    int e = tid + q * 256, st = e / 96, rem = e - st * 96, a = rem >> 4, f4 = rem & 15;
    pre[q] = make_float4(0.f, 0.f, 0.f, 0.f);
    if (st < nsteps) pre[q] = *(const float4*)(sc + (long)(row0 + st) * 3072 + a * 512 + h * 64 + f4 * 4);
  }
#pragma unroll
  for (int q = 0; q < 6; ++q) *(float4*)(buf + (tid + q * 256) * 4) = pre[q];
  __syncthreads();
  for (int c = 0; c < nch; ++c) {
    const int s0 = c * 16;
    const int n = min(16, nsteps - s0);
    if (c + 1 < nch) {
#pragma unroll
      for (int q = 0; q < 6; ++q) {
        int e = tid + q * 256, st = e / 96, rem = e - st * 96, a = rem >> 4, f4 = rem & 15;
        int gs = s0 + 16 + st;
        pre[q] = make_float4(0.f, 0.f, 0.f, 0.f);
        if (gs < nsteps) pre[q] = *(const float4*)(sc + (long)(row0 + gs) * 3072 + a * 512 + h * 64 + f4 * 4);
      }
    }
    const float* cb = buf + (c & 1) * 6144;
    for (int s = 0; s < n; ++s) {
      const float* L = cb + s * 384;
      f2 wv[4], kv[4], kkv[4], nbv[4], rv[4];
      {
        const float4 a = *(const float4*)(L + 64 + j0), b = *(const float4*)(L + 64 + j0 + 4);
        wv[0] = (f2){a.x, a.y}; wv[1] = (f2){a.z, a.w}; wv[2] = (f2){b.x, b.y}; wv[3] = (f2){b.z, b.w};
      }
      {
        const float4 a = *(const float4*)(L + 128 + j0), b = *(const float4*)(L + 128 + j0 + 4);
        kv[0] = (f2){a.x, a.y}; kv[1] = (f2){a.z, a.w}; kv[2] = (f2){b.x, b.y}; kv[3] = (f2){b.z, b.w};
      }
      {
        const float4 a = *(const float4*)(L + 256 + j0), b = *(const float4*)(L + 256 + j0 + 4);
        kkv[0] = (f2){a.x, a.y}; kkv[1] = (f2){a.z, a.w}; kkv[2] = (f2){b.x, b.y}; kkv[3] = (f2){b.z, b.w};
      }
      {
        const float4 a = *(const float4*)(L + 320 + j0), b = *(const float4*)(L + 320 + j0 + 4);
        nbv[0] = (f2){a.x, a.y}; nbv[1] = (f2){a.z, a.w}; nbv[2] = (f2){b.x, b.y}; nbv[3] = (f2){b.z, b.w};
      }
      if (OUT) {
        const float4 a = *(const float4*)(L + j0), b = *(const float4*)(L + j0 + 4);
        rv[0] = (f2){a.x, a.y}; rv[1] = (f2){a.z, a.w}; rv[2] = (f2){b.x, b.y}; rv[3] = (f2){b.z, b.w};
      }
      float vi[R];
      if (R == 4) {
        const float4 t = *(const float4*)(L + 192 + ib);
        vi[0] = t.x; vi[1] = t.y; vi[2] = t.z; vi[R - 1] = t.w;
      } else {
        const float2 t = *(const float2*)(L + 192 + ib);
        vi[0] = t.x; vi[1] = t.y;
      }
      float o[R];
#pragma unroll
      for (int rr = 0; rr < R; ++rr) {
        f2 t = S[rr][0] * kkv[0] + S[rr][1] * kkv[1] + S[rr][2] * kkv[2] + S[rr][3] * kkv[3];
        const float sum = row8_sum(t.x + t.y);
        if (isG) {
#pragma unroll
          for (int q = 0; q < 4; ++q) S[rr][q] = S[rr][q] * wv[q] + nbv[q] * sum;
        } else {
#pragma unroll
          for (int q = 0; q < 4; ++q) S[rr][q] = S[rr][q] * wv[q] + (kv[q] * vi[rr] + nbv[q] * sum);
        }
        if (OUT) {
          f2 t2 = S[rr][0] * rv[0] + S[rr][1] * rv[1] + S[rr][2] * rv[2] + S[rr][3] * rv[3];
          o[rr] = row8_sum(t2.x + t2.y);
        }
      }
      if (OUT && cg == 0) {
        float* op = buf + 12288 + s * 64 + ib;
        if (R == 4) *(float4*)op = make_float4(o[0], o[1], o[2], o[R - 1]);
        else *(float2*)op = make_float2(o[0], o[1]);
      }
    }
    if (OUT) {
      __syncthreads();
      const int tk = tid >> 4, ch = (tid & 15) * 4;
      if (tk < n) {
        const float4 o4 = *(const float4*)(buf + 12288 + tk * 64 + ch);
        const float mean = row16_sum(o4.x + o4.y + o4.z + o4.w) * (1.f / 64.f);
        const float d0 = o4.x - mean, d1 = o4.y - mean, d2 = o4.z - mean, d3 = o4.w - mean;
        const float rstd = rsqrtf(row16_sum(d0 * d0 + d1 * d1 + d2 * d2 + d3 * d3) * (1.f / 64.f) + 64e-5f);
        const float* L = cb + tk * 384;
        const float4 r4 = *(const float4*)(L + ch), k4 = *(const float4*)(L + 128 + ch), v4 = *(const float4*)(L + 192 + ch);
        const float4 rk4 = *(const float4*)(p.r_k + h * 64 + ch);
        const float4 lg = *(const float4*)(p.lnx_g + h * 64 + ch), lb = *(const float4*)(p.lnx_b + h * 64 + ch);
        const float bsum = row16_sum(r4.x * k4.x * rk4.x + r4.y * k4.y * rk4.y + r4.z * k4.z * rk4.z + r4.w * k4.w * rk4.w);
        const long row = row0 + s0 + tk;
        const float4 gt = *(const float4*)(p.P + row * ECP + 3136 + h * 64 + ch);
        ushort4 ob;
        ob.x = f2bf((d0 * rstd * lg.x + lb.x + bsum * v4.x) * siluf_(gt.x));
        ob.y = f2bf((d1 * rstd * lg.y + lb.y + bsum * v4.y) * siluf_(gt.y));
        ob.z = f2bf((d2 * rstd * lg.z + lb.z + bsum * v4.z) * siluf_(gt.z));
        ob.w = f2bf((d3 * rstd * lg.w + lb.w + bsum * v4.w) * siluf_(gt.w));
        *(ushort4*)(p.Y + row * 1024 + 512 + h * 64 + ch) = ob;
      }
    }
    if (c + 1 < nch) {
      float* nbuf = buf + ((c + 1) & 1) * 6144;
#pragma unroll
      for (int q = 0; q < 6; ++q) *(float4*)(nbuf + (tid + q * 256) * 4) = pre[q];
    }
    __syncthreads();
  }
  float* fin = isG ? fin1 : fin0;
  if (fin) {
#pragma unroll
    for (int rr = 0; rr < R; ++rr) {
      *(float4*)(fin + (ib + rr) * 64 + j0) = make_float4(S[rr][0].x, S[rr][0].y, S[rr][1].x, S[rr][1].y);
      *(float4*)(fin + (ib + rr) * 64 + j0 + 4) = make_float4(S[rr][2].x, S[rr][2].y, S[rr][3].x, S[rr][3].y);
    }
  }
}

#define P2_LOAD(G, HV, cc) { const int c_ = min((cc), NCH - 1); \
    _Pragma("unroll") for (int u = 0; u < 16; ++u) G[u] = Gh[(long)c_ * 4096 + (q * 16 + u) * 64 + j]; \
    HV = *(const float2*)(Hh + (long)c_ * 4096 + (i0 + oi) * 64 + oj); }
#define P2_STEP(G, HV, cc) { \
    *(float2*)(Sh + (long)(cc) * 4096 + (i0 + oi) * 64 + oj) = make_float2(s0, s1); \
    sS[oj * 8 + oi] = s0; sS[(oj + 1) * 8 + oi] = s1; \
    __syncthreads(); \
    float acc[8]; \
    _Pragma("unroll") for (int i = 0; i < 8; ++i) acc[i] = 0.f; \
    _Pragma("unroll") for (int u = 0; u < 16; ++u) { \
      const int jp = q * 16 + u; \
      const float4 sa = *(const float4*)(sS + jp * 8), sb = *(const float4*)(sS + jp * 8 + 4); \
      acc[0] += sa.x * G[u]; acc[1] += sa.y * G[u]; acc[2] += sa.z * G[u]; acc[3] += sa.w * G[u]; \
      acc[4] += sb.x * G[u]; acc[5] += sb.y * G[u]; acc[6] += sb.z * G[u]; acc[7] += sb.w * G[u]; } \
    _Pragma("unroll") for (int i = 0; i < 8; ++i) red[(q * 8 + i) * 64 + j] = acc[i]; \
    __syncthreads(); \
    s0 = HV.x; s1 = HV.y; \
    _Pragma("unroll") for (int qq = 0; qq < 4; ++qq) { \
      const float2 rv = *(const float2*)(red + (qq * 8 + oi) * 64 + oj); s0 += rv.x; s1 += rv.y; } }
__device__ void scan_pass2(const Params& p, int item, char* smem) {
  float* sS = (float*)smem;
  float* red = sS + 512;
  const int tid = threadIdx.x, q = tid >> 6, j = tid & 63;
  const int h = item >> 3, i0 = (item & 7) * 8;
  const int oi = tid >> 5, oj = (tid & 31) * 2;
  float s0 = 0.f, s1 = 0.f;
  const float* Gh = p.Gbuf + (long)h * NCH * 4096;
  const float* Hh = p.Hbuf + (long)h * NCH * 4096;
  float* Sh = p.Sst + (long)h * NCH * 4096;
  float g0[16], g1[16], g2[16], g3[16];
  float2 h0, h1, h2, h3;
  P2_LOAD(g0, h0, 0) P2_LOAD(g1, h1, 1) P2_LOAD(g2, h2, 2)
  __syncthreads();
  for (int c = 0; c < NCH; c += 4) {
    P2_LOAD(g3, h3, c + 3) P2_STEP(g0, h0, c)
    P2_LOAD(g0, h0, c + 4) P2_STEP(g1, h1, c + 1)
    P2_LOAD(g1, h1, c + 5) P2_STEP(g2, h2, c + 2)
    P2_LOAD(g2, h2, c + 6) P2_STEP(g3, h3, c + 3)
  }
  *(float2*)(p.wkv_p + h * 4096 + (i0 + oi) * 64 + oj) = make_float2(s0, s1);
}

DEVI void conv4(const Params& p, int row0, int ch, float& a0, float& a1, float& a2, float& a3) {
  const bool prm = row0 < T;
  const int b = (row0 - T) >> 2;
  const float* pb = p.U + (long)(row0 - 30) * 512 + ch;
  const float* pa = prm ? pb : p.state_conv + (long)(b * 30) * 512 + ch;
  float u[34];
  const float cb = p.conv_b[ch];
  a0 = cb; a1 = cb; a2 = cb; a3 = cb;
#pragma unroll
  for (int e = 0; e < 19; ++e) u[e] = pa[e * 512];
#pragma unroll
  for (int j = 0; j < 16; ++j) {
    const float wv = p.conv_w[j * 512 + ch];
    a0 += wv * u[j]; a1 += wv * u[j + 1]; a2 += wv * u[j + 2]; a3 += wv * u[j + 3];
  }
  asm volatile("" ::: "memory");
#pragma unroll
  for (int e = 19; e < 34; ++e) u[e] = (e < 30 ? pa : pb)[e * 512];
#pragma unroll
  for (int j = 16; j < 31; ++j) {
    const float wv = p.conv_w[j * 512 + ch];
    a0 += wv * u[j]; a1 += wv * u[j + 1]; a2 += wv * u[j + 2]; a3 += wv * u[j + 3];
  }
}
__device__ void conv_item(const Params& p, int grp, char* smem) {
  float* red = (float*)smem;
  const int tid = threadIdx.x, lane = tid & 63, w = tid >> 6;
  const int row0 = grp * 4;
  float acc[2][4];
  conv4(p, row0, tid, acc[0][0], acc[0][1], acc[0][2], acc[0][3]);
  asm volatile("" ::: "memory");
  conv4(p, row0, tid + 256, acc[1][0], acc[1][1], acc[1][2], acc[1][3]);
  float s[4];
#pragma unroll
  for (int r = 0; r < 4; ++r) s[r] = wave_sum(acc[0][r] + acc[1][r]);
  __syncthreads();
  if (lane == 0) { red[w * 4 + 0] = s[0]; red[w * 4 + 1] = s[1]; red[w * 4 + 2] = s[2]; red[w * 4 + 3] = s[3]; }
  __syncthreads();
  float mean[4];
#pragma unroll
  for (int r = 0; r < 4; ++r) mean[r] = (red[r] + red[4 + r] + red[8 + r] + red[12 + r]) * (1.f / 512.f);
#pragma unroll
  for (int r = 0; r < 4; ++r) {
    float d0 = acc[0][r] - mean[r], d1 = acc[1][r] - mean[r];
    s[r] = wave_sum(d0 * d0 + d1 * d1);
  }
  __syncthreads();
  if (lane == 0) { red[w * 4 + 0] = s[0]; red[w * 4 + 1] = s[1]; red[w * 4 + 2] = s[2]; red[w * 4 + 3] = s[3]; }
  __syncthreads();
#pragma unroll
  for (int hh = 0; hh < 2; ++hh) {
    const int ch = tid + hh * 256;
    const float lg = p.cln_g[ch], lb = p.cln_b[ch];
#pragma unroll
    for (int r = 0; r < 4; ++r) {
      float var = (red[r] + red[4 + r] + red[8 + r] + red[12 + r]) * (1.f / 512.f);
      float rstd = rsqrtf(var + 1e-5f);
      float y = (acc[hh][r] - mean[r]) * rstd * lg + lb;
      float gate = p.P[(long)(row0 + r) * ECP + 2624 + ch];
      p.Y[(long)(row0 + r) * 1024 + ch] = f2bf(siluf_(y) * siluf_(gate));
    }
  }
}

__device__ void phaseD1(const Params& p, int bid, int nb, char* smem) {
  for (int it = bid; it < 8 * NCH; it += nb) {
    const int h = it / NCH, c = it - h * NCH;
    scan_chunk<4, true>(p, h, c * CH, CH, nullptr, p.Hbuf + (long)it * 4096, p.Gbuf + (long)it * 4096, smem);
  }
  for (int it = bid; it < 256; it += nb) {
    const int b = it >> 3, h = it & 7;
    scan_chunk<2, false>(p, h, T + b * 4, 4, p.state_wkv + (long)it * 4096, p.wkv_s + (long)it * 4096, nullptr, smem);
  }
  for (int g = bid; g < MT / 4; g += nb) conv_item(p, g, smem);
}
__device__ void phaseD2(const Params& p, int bid, int nb, char* smem) {
  if (bid < 64) { scan_pass2(p, bid, smem); return; }
  copy_cache<128>(p.cache0, p.kvs0, bid - 64, nb - 64);
  copy_cache<512>(p.cache1, p.kvs1, bid - 64, nb - 64);
  copy_cache<2048>(p.cache2, p.kvs2, bid - 64, nb - 64);
}
__device__ void phaseD3(const Params& p, int bid, int nb, char* smem) {
  for (int it = bid; it < 8 * NCH; it += nb) {
    const int h = it / NCH, c = it - h * NCH;
    scan_chunk<2, false>(p, h, c * CH, CH, p.Sst + (long)it * 4096, nullptr, nullptr, smem);
  }
}

__device__ void conv_state_out(const Params& p, int bid, int nb) {
  for (int i = bid * 256 + threadIdx.x; i < 15360 + 491520; i += nb * 256) {
    if (i < 15360) p.conv_p[i] = p.U[(long)(T - 30) * 512 + i];
    else {
      int q = i - 15360, b = q / 15360, rem = q - b * 15360, r = rem >> 9, ch = rem & 511;
      p.conv_s[q] = r < 26 ? p.state_conv[(long)(b * 30 + r + 4) * 512 + ch] : p.U[(long)(T + b * 4 + r - 26) * 512 + ch];
    }
  }
}

__device__ void ln_phase(const float* __restrict__ Z, const float* res0, const float* res1,
                         const float* __restrict__ g, const float* __restrict__ bta,
                         float* out0, float* out1, u16* outb, int bid, int nb) {
  const int lane = threadIdx.x & 63, w = threadIdx.x >> 6;
  for (int row = bid * 4 + w; row < MT; row += nb * 4) {
    const float4* z4 = (const float4*)(Z + (long)row * 1024);
    float4 v[4];
    float s = 0.f;
    const float4* r4 =(const float4*)(row < T ? res0 + (long)row * 1024 : res1 + (long)(row - T) * 1024);
#pragma unroll
    for (int i = 0; i < 4; ++i) {
      float4 z = z4[lane + i * 64], r = r4[lane + i * 64];
      v[i].x = z.x + ALPHA * r.x; v[i].y = z.y + ALPHA * r.y; v[i].z = z.z + ALPHA * r.z; v[i].w = z.w + ALPHA * r.w;
      s += v[i].x + v[i].y + v[i].z + v[i].w;
    }
    float mean = wave_sum(s) * (1.f / 1024.f);
    float q = 0.f;
#pragma unroll
    for (int i = 0; i < 4; ++i) {
      float a = v[i].x - mean, b = v[i].y - mean, c = v[i].z - mean, d = v[i].w - mean;
      q += a * a + b * b + c * c + d * d;
    }
    float rstd = rsqrtf(wave_sum(q) * (1.f / 1024.f) + 1e-5f);
    float* op = row < T ? out0 + (long)row * 1024 : out1 + (long)(row - T) * 1024;
#pragma unroll
    for (int i = 0; i < 4; ++i) {
      float4 gg = ((const float4*)g)[lane + i * 64], bb = ((const float4*)bta)[lane + i * 64];
      float4 o;
      o.x = (v[i].x - mean) * rstd * gg.x + bb.x;
      o.y = (v[i].y - mean) * rstd * gg.y + bb.y;
      o.z = (v[i].z - mean) * rstd * gg.z + bb.z;
      o.w = (v[i].w - mean) * rstd * gg.w + bb.w;
      ((float4*)op)[lane + i * 64] = o;
      if (outb) {
        ushort4 ob;
        ob.x = f2bf(o.x); ob.y = f2bf(o.y); ob.z = f2bf(o.z); ob.w = f2bf(o.w);
        ((ushort4*)(outb + (long)row * 1024))[lane + i * 64] = ob;
      }
    }
  }
}

DEVI float bf2f(u16 v) { return __uint_as_float((unsigned)v << 16); }
struct AttnItem { int g, dil, h, c, l0, qoff; };
DEVI AttnItem attn_decode(int item) {
  AttnItem a;
  a.g = item >> 11;
  const int rem = item & 2047;
  a.dil = a.g == 0 ? 1 : (a.g == 1 ? 4 : 16);
  const int nlb = (T / a.dil) >> 6;
  a.h = rem & 7;
  const int cl = rem >> 3;
  a.c = cl / nlb;
  a.l0 = (cl - a.c * nlb) * 64;
  a.qoff = a.g * 512 + a.h * 64;
  return a;
}
DEVI void attn_load_qk(const Params& p, const AttnItem& a, uint4& rq0, uint4& rq1, uint4 (&rk)[6]) {
  const int tid = threadIdx.x;
  const u16* __restrict__ Q = p.QKVG;
  {
    const int row = tid >> 3, cc = tid & 7;
    rq0 = *(const uint4*)(Q + ((long)(a.l0 + row) * a.dil + a.c) * OC + a.qoff + cc * 8);
    rq1 = *(const uint4*)(Q + ((long)(a.l0 + row + 32) * a.dil + a.c) * OC + a.qoff + cc * 8);
  }
#pragma unroll
  for (int i = 0; i < 6; ++i) {
    const int ch = tid + i * 256, row = ch >> 3, cc = ch & 7;
    const int lp = a.l0 - 128 + row;
    rk[i] = make_uint4(0u, 0u, 0u, 0u);
    if (lp >= 0) rk[i] = *(const uint4*)(Q + ((long)lp * a.dil + a.c) * OC + 1536 + a.qoff + cc * 8);
  }
}
DEVI void attn_load_v(const Params& p, const AttnItem& a, uint4 (&rv)[8]) {
  const int tid = threadIdx.x;
  const u16* __restrict__ Q = p.QKVG;
#pragma unroll
  for (int i = 0; i < 2; ++i) {
    const int task = tid + i * 256, kq = task >> 3, dq = task & 7;
#pragma unroll
    for (int u = 0; u < 4; ++u) {
      const int ki = kq * 4 + u, lp = a.l0 - 128 + ki;
      rv[i * 4 + u] = make_uint4(0u, 0u, 0u, 0u);
      if (task < 416 && ki < 192 && lp >= 0)
        rv[i * 4 + u] = *(const uint4*)(Q + ((long)lp * a.dil + a.c) * OC + 3072 + a.qoff + dq * 8);
    }
  }
}
DEVI unsigned pk_lo(unsigned a, unsigned b) { return (a & 0xffffu) | (b << 16); }
DEVI unsigned pk_hi(unsigned a, unsigned b) { return (a >> 16) | (b & 0xffff0000u); }
DEVI void attn_store_v(u16* sVt, const uint4 (&rv)[8]) {
  const int tid = threadIdx.x;
#pragma unroll
  for (int i = 0; i < 2; ++i) {
    const int task = tid + i * 256, kq = task >> 3, dq = task & 7;
    if (task < 416) {
      const uint4 v0 = rv[i * 4], v1 = rv[i * 4 + 1], v2 = rv[i * 4 + 2], v3 = rv[i * 4 + 3];
      u16* base = sVt + (dq * 8) * 208 + kq * 4;
      *(uint2*)(base + 0 * 208) = make_uint2(pk_lo(v0.x, v1.x), pk_lo(v2.x, v3.x));
      *(uint2*)(base + 1 * 208) = make_uint2(pk_hi(v0.x, v1.x), pk_hi(v2.x, v3.x));
      *(uint2*)(base + 2 * 208) = make_uint2(pk_lo(v0.y, v1.y), pk_lo(v2.y, v3.y));
      *(uint2*)(base + 3 * 208) = make_uint2(pk_hi(v0.y, v1.y), pk_hi(v2.y, v3.y));
      *(uint2*)(base + 4 * 208) = make_uint2(pk_lo(v0.z, v1.z), pk_lo(v2.z, v3.z));
      *(uint2*)(base + 5 * 208) = make_uint2(pk_hi(v0.z, v1.z), pk_hi(v2.z, v3.z));
      *(uint2*)(base + 6 * 208) = make_uint2(pk_lo(v0.w, v1.w), pk_lo(v2.w, v3.w));
      *(uint2*)(base + 7 * 208) = make_uint2(pk_hi(v0.w, v1.w), pk_hi(v2.w, v3.w));
    }
  }
}

__device__ void attn_prompt_phase(const Params& p, int bid, int nb, char* smem) {
  u16* sQ = (u16*)smem;
  u16* sK = sQ + 64 * 72;
  u16* sVt = sK;
  u16* sP = sK + 192 * 72;
  const int tid = threadIdx.x, lane = tid & 63, w = tid >> 6, lr = lane & 15, lq = lane >> 4;
  uint4 rq0, rq1, rk[6], rv[8];
  { AttnItem a = attn_decode(min(bid, 6143)); attn_load_qk(p, a, rq0, rq1, rk); }
  for (int item = bid; item < 6144; item += nb) {
    const AttnItem a = attn_decode(item);
    __syncthreads();
    *(uint4*)&sQ[(tid >> 3) * 72 + (tid & 7) * 8] = rq0;
    *(uint4*)&sQ[((tid >> 3) + 32) * 72 + (tid & 7) * 8] = rq1;
#pragma unroll
    for (int i = 0; i < 6; ++i) { const int ch = tid + i * 256; *(uint4*)&sK[(ch >> 3) * 72 + (ch & 7) * 8] = rk[i]; }
    __syncthreads();
    attn_load_v(p, a, rv);
    bf16x8 qf[2];
    qf[0] = *(const bf16x8*)&sQ[(w * 16 + lr) * 72 + lq * 8];
    qf[1] = *(const bf16x8*)&sQ[(w * 16 + lr) * 72 + 32 + lq * 8];
    f32x4 s[9];
#pragma unroll
    for (int kt = 0; kt < 9; ++kt) {
      s[kt] = (f32x4){0.f, 0.f, 0.f, 0.f};
#pragma unroll
      for (int ks = 0; ks < 2; ++ks) {
        bf16x8 kf = *(const bf16x8*)&sK[((w + kt) * 16 + lr) * 72 + ks * 32 + lq * 8];
        s[kt] = __builtin_amdgcn_mfma_f32_16x16x32_bf16(qf[ks], kf, s[kt], 0, 0, 0);
      }
    }
    float m[4], sum[4];
#pragma unroll
    for (int j = 0; j < 4; ++j) {
      float mx = -1e30f;
#pragma unroll
      for (int kt = 0; kt < 9; ++kt) {
        int delta = lq * 4 + j + 128 - kt * 16 - lr;
        int lp = a.l0 - 128 + (w + kt) * 16 + lr;
        bool valid = (delta >= 0) && (delta <= 128) && (lp >= 0);
        float v = valid ? s[kt][j] : -1e30f;
        s[kt][j] = v;
        mx = fmaxf(mx, v);
      }
      mx = row16_max(mx);
      float sm = 0.f;
#pragma unroll
      for (int kt = 0; kt < 9; ++kt) {
        float pe = s[kt][j] > -1e29f ? __expf(s[kt][j] - mx) : 0.f;
        s[kt][j] = pe;
        sm += pe;
      }
      m[j] = mx;
      sum[j] = row16_sum(sm);
    }
    u16* wp = sP + w * 16 * 168;
#pragma unroll
    for (int j = 0; j < 4; ++j) {
#pragma unroll
      for (int kt = 0; kt < 9; ++kt) wp[(lq * 4 + j) * 168 + kt * 16 + lr] = f2bf(s[kt][j]);
      wp[(lq * 4 + j) * 168 + 144 + lr] = 0;
    }
    __syncthreads();
    attn_store_v(sVt, rv);
    { AttnItem an = attn_decode(min(item + nb, 6143)); attn_load_qk(p, an, rq0, rq1, rk); }
    __syncthreads();
    f32x4 o[4];
#pragma unroll
    for (int nt = 0; nt < 4; ++nt) o[nt] = (f32x4){0.f, 0.f, 0.f, 0.f};
#pragma unroll
    for (int ks = 0; ks < 5; ++ks) {
      bf16x8 pf = *(const bf16x8*)&wp[lr * 168 + ks * 32 + lq * 8];
#pragma unroll
      for (int nt = 0; nt < 4; ++nt) {
        bf16x8 vf = *(const bf16x8*)&sVt[(nt * 16 + lr) * 208 + w * 16 + ks * 32 + lq * 8];
        o[nt] = __builtin_amdgcn_mfma_f32_16x16x32_bf16(pf, vf, o[nt], 0, 0, 0);
      }
    }
#pragma unroll
    for (int j = 0; j < 4; ++j) {
      long t = (long)(a.l0 + w * 16 + lq * 4 + j) * a.dil + a.c;
      float inv = 1.f / sum[j];
#pragma unroll
      for (int nt = 0; nt < 4; ++nt) p.AO[((long)a.g * MT + t) * 512 + a.h * 64 + nt * 16 + lr] = o[nt][j] * inv;
      if (lr == 0) p.LSE[((long)a.g * MT + t) * 8 + a.h] = m[j] + __logf(sum[j]);
    }
  }
}

__device__ void attn_sample_item(const Params& p, int witem, float* sp) {
  const int lane = threadIdx.x & 63;
  const int h = witem & 7, g = (witem >> 3) % 3, bs = witem / 24, b = bs >> 2, s = bs & 3;
  const int dil = g == 0 ? 1 : (g == 1 ? 4 : 16);
  const int W = g == 0 ? 128 : (g == 1 ? 512 : 2048);
  const float* cache = g == 0 ? p.cache0 : (g == 1 ? p.cache1 : p.cache2);
  const int row = T + b * 4 + s;
  const u16* q = p.QKVG + (long)row * OC + g * 512 + h * 64;
  float sc[3];
#pragma unroll
  for (int u = 0; u < 3; ++u) {
    int j = lane + u * 64;
    sc[u] = -1e30f;
    if (j <= 128) {
      int idx = W + s - dil * j;
      float d = 0.f;
      if (idx >= W) {
        const u16* kp = p.QKVG + (long)(T + b * 4 + idx - W) * OC + 1536 + g * 512 + h * 64;
#pragma unroll 4
        for (int f = 0; f < 64; ++f) d += bf2f(kp[f]) * bf2f(q[f]);
      } else {
        const float* kp = cache + ((long)(b * W + idx) * 2) * 512 + h * 64;
#pragma unroll 4
        for (int f = 0; f < 16; ++f) {
          float4 kv = *(const float4*)(kp + f * 4);
          ushort4 qv = *(const ushort4*)(q + f * 4);
          d += kv.x * bf2f(qv.x) + kv.y * bf2f(qv.y) + kv.z * bf2f(qv.z) + kv.w * bf2f(qv.w);
        }
      }
      sc[u] = d;
    }
  }
  float mx = wave_max(fmaxf(fmaxf(sc[0], sc[1]), sc[2]));
  float sm = 0.f;
#pragma unroll
  for (int u = 0; u < 3; ++u) {
    int j = lane + u * 64;
    float pe = j <= 128 ? __expf(sc[u] - mx) : 0.f;
    sm += pe;
    if (j <= 128) sp[j] = pe;
  }
  sm = wave_sum(sm);
  __builtin_amdgcn_s_waitcnt(0);
  __builtin_amdgcn_wave_barrier();
  float o = 0.f;
  for (int j = 0; j <= 128; ++j) {
    int idx = W + s - dil * j;
    float vv;
    if (idx >= W) vv = bf2f(p.QKVG[(long)(T + b * 4 + idx - W) * OC + 3072 + g * 512 + h * 64 + lane]);
    else vv = cache[((long)(b * W + idx) * 2 + 1) * 512 + h * 64 + lane];
    o += sp[j] * vv;
  }
  p.AO[((long)g * MT + row) * 512 + h * 64 + lane] = o / sm;
  if (lane == 0) p.LSE[((long)g * MT + row) * 8 + h] = mx + __logf(sm);
  __builtin_amdgcn_wave_barrier();
}

__device__ void phaseI(const Params& p, int bid, int nb, char* smem) {
  attn_prompt_phase(p, bid, nb, smem);
  __syncthreads();
  float* sp = (float*)smem + (threadIdx.x >> 6) * 160;
  for (int it = bid * 4 + (threadIdx.x >> 6); it < 3072; it += nb * 4) attn_sample_item(p, it, sp);
}

DEVI float4 bf4_to_f4(uint2 v) {
  return make_float4(__uint_as_float(v.x << 16), __uint_as_float(v.x & 0xffff0000u), __uint_as_float(v.y << 16),
                     __uint_as_float(v.y & 0xffff0000u));
}
__device__ void copy_kv_out(const Params& p, int g, int W, float* kvp, float* kvs, int bid, int nb) {
  const u16* Q = p.QKVG;
  const int np = W * 256;
  const int ns = 32 * 4 * 256;
  for (int i = bid * 256 + threadIdx.x; i < np + ns; i += nb * 256) {
    if (i < np) {
      int r = i >> 8, rem = i & 255, kv = rem >> 7, c4 = rem & 127;
      ((float4*)kvp)[i] = bf4_to_f4(*(const uint2*)(Q + (long)(T - W + r) * OC + 1536 + kv * 1536 + g * 512 + c4 * 4));
    } else {
      int q = i - np, bs = q >> 8, rem = q & 255, kv = rem >> 7, c4 = rem & 127, b = bs >> 2, s = bs & 3;
      ((float4*)kvs)[((long)(b * W + W - 4 + s) * 2 + kv) * 128 + c4] =
          bf4_to_f4(*(const uint2*)(Q + (long)(T + bs) * OC + 1536 + kv * 1536 + g * 512 + c4 * 4));
    }
  }
}

__device__ void phaseI2(const Params& p, int bid, int nb) {
  const int tid = threadIdx.x;
  for (int i = bid * 256 + tid; i < MT * 128; i += nb * 256) {
    int row = i >> 7, c4 = i & 127, h = c4 >> 4;
    float l0 = p.LSE[((long)row) * 8 + h], l1 = p.LSE[((long)MT + row) * 8 + h], l2 = p.LSE[((long)2 * MT + row) * 8 + h];
    float mx = fmaxf(l0, fmaxf(l1, l2));
    float e0 = __expf(l0 - mx), e1 = __expf(l1 - mx), e2 = __expf(l2 - mx);
    float inv = 1.f / (e0 + e1 + e2);
    e0 *= inv; e1 *= inv; e2 *= inv;
    float4 a0 = ((const float4*)p.AO)[(long)row * 128 + c4];
    float4 a1 = ((const float4*)p.AO)[((long)MT + row) * 128 + c4];
    float4 a2 = ((const float4*)p.AO)[((long)2 * MT + row) * 128 + c4];
    float4 gt = bf4_to_f4(*(const uint2*)(p.QKVG + (long)row * OC + 4608 + c4 * 4));
    ushort4 ob;
    ob.x = f2bf((e0 * a0.x + e1 * a1.x + e2 * a2.x) * siluf_(gt.x));
    ob.y = f2bf((e0 * a0.y + e1 * a1.y + e2 * a2.y) * siluf_(gt.y));
    ob.z = f2bf((e0 * a0.z + e1 * a1.z + e2 * a2.z) * siluf_(gt.z));
    ob.w = f2bf((e0 * a0.w + e1 * a1.w + e2 * a2.w) * siluf_(gt.w));
    ((ushort4*)p.O2)[(long)row * 128 + c4] = ob;
  }
  copy_kv_out(p, 0, 128, p.kvp0, p.kvs0, bid, nb);
  copy_kv_out(p, 1, 512, p.kvp1, p.kvs1, bid, nb);
  copy_kv_out(p, 2, 2048, p.kvp2, p.kvs2, bid, nb);
}

#define XB_TMO      128
#define XB_XCNT(j)  (256  + 64 * (j))
#define XB_XSUB(j)  (1280 + 64 * (j))
#define XB_XGEN(j)  (2304 + 64 * (j))
#define XB_TOP      3328
#define XB_TOPGEN   3392
#define XCD_BAR_WORDS 3456
#define XB_SPIN_CAP (1u << 18)
#define LAS __attribute__((address_space(3)))

__device__ __forceinline__ unsigned xb_ld(unsigned* p)              { return __hip_atomic_load(p, __ATOMIC_RELAXED, __HIP_MEMORY_SCOPE_AGENT); }
__device__ __forceinline__ unsigned xb_add(unsigned* p, unsigned v) { return __hip_atomic_fetch_add(p, v, __ATOMIC_RELAXED, __HIP_MEMORY_SCOPE_AGENT); }
__device__ __forceinline__ unsigned xb_xcc_id() { return (unsigned)__builtin_amdgcn_s_getreg((3 << 11) | 20) & 0xFu; }
#define XB_SPIN(cond, bar) do { unsigned _sp = 0; while (cond) { __builtin_amdgcn_s_sleep(1); \
    if ((++_sp & 255u) == 0u) { if (xb_ld(&(bar)[XB_TMO])) break; if (_sp > XB_SPIN_CAP) { atomicAdd(&(bar)[XB_TMO], 1u); break; } } } } while (0)

struct XcdBarrier {
    unsigned* bar; unsigned x;
    volatile LAS unsigned* st;
};

__device__ __forceinline__ XcdBarrier xcd_barrier_post(unsigned* bar, volatile LAS unsigned* st) {
    XcdBarrier b; b.bar = bar; b.x = xb_xcc_id(); b.st = st;
    if (threadIdx.x == 0) (void)xb_add(&bar[XB_XCNT(b.x)], 1u);
    return b;
}
__device__ __forceinline__ void xcd_barrier_complete(unsigned* bar, unsigned x, unsigned& nloc, unsigned& nx) {
    const unsigned G = gridDim.x * gridDim.y * gridDim.z;
    unsigned sum, cnt, mine, sp = 0u;
    for (;;) {
        sum = 0u; cnt = 0u; mine = 0u;
#pragma unroll
        for (unsigned j = 0; j < 16; ++j) { const unsigned c = xb_ld(&bar[XB_XCNT(j)]); sum += c; cnt += (c > 0u) ? 1u : 0u; mine = (j == x) ? c : mine; }
        if (sum == G) break;
        __builtin_amdgcn_s_sleep(1);
        if ((++sp & 255u) == 0u) { if (xb_ld(&bar[XB_TMO])) break; if (sp > XB_SPIN_CAP) { atomicAdd(&bar[XB_TMO], 1u); break; } }
    }
    nloc = mine > 0u ? mine : 1u; nx = cnt > 0u ? cnt : 1u;
}

__device__ __forceinline__ void xcd_barrier(const XcdBarrier& b) {
    asm volatile("s_waitcnt vmcnt(0)" ::: "memory");
    __syncthreads();
    if (threadIdx.x == 0) {
        unsigned* bar = b.bar;
        __builtin_amdgcn_s_waitcnt(0);
        unsigned nloc = b.st[0], nx = b.st[1];
        if (nloc == 0u) { xcd_barrier_complete(bar, b.x, nloc, nx); b.st[0] = nloc; b.st[1] = nx; }
        const unsigned old = xb_add(&bar[XB_XSUB(b.x)], 1u);
        const unsigned gen = old / nloc;
        if (old + 1u == (gen + 1u) * nloc) {
            __builtin_amdgcn_fence(__ATOMIC_RELEASE, "agent");
            asm volatile("s_waitcnt vmcnt(0)" ::: "memory");
            const unsigned og = xb_add(&bar[XB_TOP], 1u);
            const unsigned tg = og / nx;
            if (og + 1u == (tg + 1u) * nx) xb_add(&bar[XB_TOPGEN], 1u);
            else XB_SPIN(xb_ld(&bar[XB_TOPGEN]) == tg, bar);
            __builtin_amdgcn_fence(__ATOMIC_ACQUIRE, "agent");
            xb_add(&bar[XB_XGEN(b.x)], 1u);
            asm volatile("s_waitcnt vmcnt(0)" ::: "memory");
        } else {
            XB_SPIN(xb_ld(&bar[XB_XGEN(b.x)]) == gen, bar);
            __builtin_amdgcn_fence(__ATOMIC_ACQUIRE, "agent");
            asm volatile("s_waitcnt vmcnt(0)" ::: "memory");
        }
    }
    __syncthreads();
}


template <int PH> DEVI void run_phase(const Params& p, int bid, int nb, char* smem) {
  if (PH == 0) phaseA(p, bid, nb, smem);
  if (PH == 1) gemm_big<0>(p.Xb, p.WinE, 1024, 65, 29, p.P, ECP, bid, nb, smem);
  if (PH == 2) phaseC(p, bid, nb, smem);
  if (PH == 3) phaseD1(p, bid, nb, smem);
  if (PH == 4) phaseD2(p, bid, nb, smem);
  if (PH == 5) { phaseD3(p, bid, nb, smem); conv_state_out(p, bid, nb); }
  if (PH == 6) gemm_phase<0>(p.Y, p.WoutE, 1024, 129, 8, p.Z, 1024, nullptr, nullptr, bid, nb, smem);
  if (PH == 7) ln_phase(p.Z, p.x_prompt, p.x_sample, p.ln_g, p.ln_b, p.X1, p.X1 + (long)T * 1024, p.X1b, bid, nb);
  if (PH == 8) gemm_big<2>(p.X1b, p.WinO, 1024, 65, 40, (float*)p.QKVG, OC, bid, nb, smem);
  if (PH == 9) phaseI(p, bid, nb, smem);
  if (PH == 10) phaseI2(p, bid, nb);
  if (PH == 11) gemm_phase<0>(p.O2, p.WoutO, 512, 129, 8, p.Z, 1024, nullptr, nullptr, bid, nb, smem);
  if (PH == 12) ln_phase(p.Z, p.X1, p.X1 + (long)T * 1024, p.ln_g + 1024, p.ln_b + 1024, p.y_prompt, p.y_sample, nullptr, bid, nb);
}
constexpr int NPH = 13;
template <int PH> DEVI void run_all(const Params& p, int bid, int nb, char* smem, const XcdBarrier& xb) {
  run_phase<PH>(p, bid, nb, smem);
  if constexpr (((REPMASK) >> PH) & 1) { xcd_barrier(xb); run_phase<PH>(p, bid, nb, smem); }
  if constexpr (PH + 1 < NPH) { xcd_barrier(xb); run_all<PH + 1>(p, bid, nb, smem, xb); }
}

#if MEGA
__global__ void __launch_bounds__(256, 2) mega_kernel(Params p) {
  __shared__ __attribute__((aligned(16))) char smem[SMEM_BYTES];
  __shared__ uint4 xb_words;
  const int bid = blockIdx.x, nb = gridDim.x;
  if (threadIdx.x == 0) xb_words = make_uint4(0u, 0u, 0u, 0u);
  __syncthreads();
  XcdBarrier xb = xcd_barrier_post(p.bar, (volatile LAS unsigned*)&xb_words);
  if (p.bar == nullptr) cg::this_grid().sync();
#ifdef XSYNC
  for (int i = 0; i < XSYNC; ++i) xcd_barrier(xb);
#endif
  run_all<0>(p, bid, nb, smem, xb);
}
#else
template <int PH> __global__ void __launch_bounds__(256, 2) phase_kernel(Params p) {
  __shared__ __attribute__((aligned(16))) char smem[SMEM_BYTES];
  run_phase<PH>(p, blockIdx.x, gridDim.x, smem);
}
#endif

extern "C" void kernel_launch(void* const* d_in, const int* in_sizes, int n_in, void* d_out, int out_size,
                              void* d_ws, size_t ws_size, hipStream_t stream) {
  Params p{};
  const float** ins = (const float**)&p.x_prompt;
  for (int i = 0; i < 28; ++i) ins[i] = (const float*)d_in[i];
  float* o = (float*)d_out;
  p.y_prompt = o; o += 16777216;
  p.y_sample = o; o += 131072;
  p.conv_p = o; o += 15360;
  p.conv_s = o; o += 491520;
  p.shift_p = o; o += 1024;
  p.shift_s = o; o += 32768;
  p.wkv_p = o; o += 32768;
  p.wkv_s = o; o += 1048576;
  p.kvp0 = o; o += 131072;
  p.kvs0 = o; o += 4194304;
  p.kvp1 = o; o += 524288;
  p.kvs1 = o; o += 16777216;
  p.kvp2 = o; o += 2097152;
  p.kvs2 = o; o += 67108864;
  char* w = (char*)d_ws;
  size_t off = 0;
  auto take = [&](size_t bytes) { char* r = w + off; off += (bytes + 255) & ~(size_t)255; return r; };
  p.Xb = (u16*)take((size_t)MP * 1024 * 2);
  p.WinE = (u16*)take((size_t)ECP * 1024 * 2);
  p.WoutE = (u16*)take((size_t)1024 * 1024 * 2);
  p.WinO = (u16*)take((size_t)OC * 1024 * 2);
  p.WoutO = (u16*)take((size_t)1024 * 512 * 2);
  p.Y = (u16*)take((size_t)MP * 1024 * 2);
  p.X1b = (u16*)take((size_t)MP * 1024 * 2);
  p.O2 = (u16*)take((size_t)MP * 512 * 2);
  p.Z = (float*)take((size_t)MP * 1024 * 4);
  p.X1 = (float*)take((size_t)MP * 1024 * 4);
  size_t offB = off;
  p.P = (float*)take((size_t)MP * ECP * 4);
  p.scan = (float*)take((size_t)6 * SCAN_STRIDE * 4);
  p.U = (float*)take((size_t)(SCAN_STRIDE + 30 * 512) * 4) + 30 * 512;
  p.Oraw = (float*)take((size_t)SCAN_STRIDE * 4);
  p.Gbuf = (float*)take((size_t)8 * NCH * 4096 * 4);
  p.Hbuf = (float*)take((size_t)8 * NCH * 4096 * 4);
  p.Sst = (float*)take((size_t)8 * NCH * 4096 * 4);
  off = offB;
  p.QKVG = (u16*)take((size_t)MP * OC * 2);
  p.AO = (float*)take((size_t)3 * SCAN_STRIDE * 4);
  p.LSE = (float*)take((size_t)3 * MT * 8 * 4);
  off = (size_t)900 << 20;
  p.bar = (unsigned*)take((size_t)XCD_BAR_WORDS * 4);
#if MEGA
  static int grid_blocks = 0;
  if (!grid_blocks) {
    int dev = 0, cus = 0, per_cu = 0;
    hipGetDevice(&dev);
    hipDeviceGetAttribute(&cus, hipDeviceAttributeMultiprocessorCount, dev);
    hipOccupancyMaxActiveBlocksPerMultiprocessor(&per_cu, mega_kernel, 256, 0);
    if (per_cu > 2) per_cu = 2;
    grid_blocks = cus * per_cu;
  }
  hipMemsetAsync(p.bar, 0, (size_t)XCD_BAR_WORDS * 4, stream);
  void* args[] = {&p};
  hipError_t e = hipLaunchCooperativeKernel((void*)mega_kernel, dim3(grid_blocks), dim3(256), args, 0, stream);
  if (e != hipSuccess) fprintf(stderr, "cooperative launch failed: %s (grid %d)\n", hipGetErrorString(e), grid_blocks);
#else
  const int G = 1024;
  phase_kernel<0><<<G, 256, 0, stream>>>(p);
  phase_kernel<1><<<G, 256, 0, stream>>>(p);
  phase_kernel<2><<<G, 256, 0, stream>>>(p);
  phase_kernel<3><<<G, 256, 0, stream>>>(p);
  phase_kernel<4><<<G, 256, 0, stream>>>(p);
  phase_kernel<5><<<G, 256, 0, stream>>>(p);
  phase_kernel<6><<<G, 256, 0, stream>>>(p);
  phase_kernel<7><<<G, 256, 0, stream>>>(p);
  phase_kernel<8><<<G, 256, 0, stream>>>(p);
  phase_kernel<9><<<G, 256, 0, stream>>>(p);
  phase_kernel<10><<<G, 256, 0, stream>>>(p);
  phase_kernel<11><<<G, 256, 0, stream>>>(p);
  phase_kernel<12><<<G, 256, 0, stream>>>(p);
#endif
}
```

```cpp
#include <hip/hip_runtime.h>
#include <hip/hip_bf16.h>
#include <hip/hip_cooperative_groups.h>
#include <cstdio>
namespace cg = cooperative_groups;

#ifndef MEGA
#define MEGA 1
#endif
#ifndef REPMASK
#define REPMASK 0
#endif

typedef __attribute__((ext_vector_type(8))) short bf16x8;
typedef __attribute__((ext_vector_type(4))) float f32x4;
typedef unsigned short u16;
#define DEVI __device__ __forceinline__

constexpr int T = 16384;
constexpr int NS = 128;
constexpr int MT = T + NS;
constexpr int MX = MT + 32;
constexpr int MP = 16640;
constexpr int EC = 3648, ECP = 3712, OC = 5120;
constexpr float ALPHA = 1.41421356237f;
constexpr int SCAN_STRIDE = MT * 512;
constexpr int SMEM_BYTES = 61440;

struct Params {
  const float *x_prompt, *x_sample, *state_conv, *state_shift, *state_wkv, *cache0, *cache1, *cache2;
  const float *w_in_even, *conv_w, *conv_b, *cln_g, *cln_b, *mu, *w0, *w2, *a0, *a2, *k_k, *k_a, *r_k,
      *lnx_g, *lnx_b, *w_out_even, *w_in_odd, *w_out_odd, *ln_g, *ln_b;
  float *y_prompt, *y_sample, *conv_p, *conv_s, *shift_p, *shift_s, *wkv_p, *wkv_s, *kvp0, *kvs0, *kvp1, *kvs1,
      *kvp2, *kvs2;
  u16 *Xb, *WinE, *WoutE, *WinO, *WoutO, *Y, *X1b, *O2;
  float *Z, *X1, *P, *scan, *U, *Oraw, *AO, *LSE, *Gbuf, *Hbuf, *Sst;
  u16* QKVG;
  unsigned* bar;
};

DEVI u16 f2bf(float f) {
  unsigned u = __float_as_uint(f);
  u += 0x7fffu + ((u >> 16) & 1u);
  return (u16)(u >> 16);
}
template <int CTRL> DEVI float dppf(float x) {
  return __builtin_bit_cast(float, __builtin_amdgcn_mov_dpp(__builtin_bit_cast(int, x), CTRL, 0xf, 0xf, true));
}
DEVI float row16_sum(float x) {
  x += dppf<0x128>(x);
  x += dppf<0x124>(x);
  x += dppf<0x4E>(x);
  x += dppf<0xB1>(x);
  return x;
}
DEVI float row16_max(float x) {
  x = fmaxf(x, dppf<0x128>(x));
  x = fmaxf(x, dppf<0x124>(x));
  x = fmaxf(x, dppf<0x4E>(x));
  x = fmaxf(x, dppf<0xB1>(x));
  return x;
}
DEVI float wave_sum(float v) {
  v = row16_sum(v);
  v += __shfl_xor(v, 16);
  v += __shfl_xor(v, 32);
  return v;
}
DEVI float wave_max(float v) {
  v = row16_max(v);
  v = fmaxf(v, __shfl_xor(v, 16));
  v = fmaxf(v, __shfl_xor(v, 32));
  return v;
}
DEVI float frcp(float x) { return __builtin_amdgcn_rcpf(x); }
DEVI float sigmoidf_(float x) { return frcp(1.f + __expf(-x)); }
DEVI float siluf_(float x) { return x * frcp(1.f + __expf(-x)); }
DEVI int prev_row(int row) {
  if (row < T) return row - 1;
  int q = row - T;
  if (q & 3) return row - 1;
  return MT + (q >> 2);
}

__device__ void transpose_tile(const float* __restrict__ W, u16* __restrict__ Wt, int K, int N, int tk, int tn,
                               float* lds) {
  const int tid = threadIdx.x;
  const int k0 = tk * 64, n0 = tn * 64;
  __syncthreads();
  for (int e = tid; e < 4096; e += 256) {
    int kk = e >> 6, nn = e & 63;
    int n = n0 + nn;
    lds[kk * 65 + nn] = (n < N) ? W[(long)(k0 + kk) * N + n] : 0.f;
  }
  __syncthreads();
  for (int e = tid; e < 4096; e += 256) {
    int nn = e >> 6, kk = e & 63;
    Wt[(long)(n0 + nn) * K + k0 + kk] = f2bf(lds[kk * 65 + nn]);
  }
}

template <int W>
__device__ void copy_cache(const float* __restrict__ src, float* __restrict__ dst, int bid, int nb) {
  constexpr int per_b = (W - 4) * 256;
  constexpr int total = 32 * per_b;
  const f32x4* s4 = (const f32x4*)src;
  f32x4* d4 = (f32x4*)dst;
  const int stride = nb * 256;
  for (int i = bid * 256 + threadIdx.x; i < total; i += 4 * stride) {
    f32x4 v[4];
    int o[4];
#pragma unroll
    for (int k = 0; k < 4; ++k) {
      const int idx = i + k * stride;
      const int ii = min(idx, total - 1);
      const int b = ii / per_b, rem = ii - b * per_b;
      o[k] = idx < total ? b * (W * 256) + rem : -1;
      v[k] = __builtin_nontemporal_load(&s4[b * (W * 256) + rem + 1024]);
    }
#pragma unroll
    for (int k = 0; k < 4; ++k)
      if (o[k] >= 0) __builtin_nontemporal_store(v[k], &d4[o[k]]);
  }
}

__device__ void phaseA(const Params& p, int bid, int nb, char* smem) {
  const int tid = threadIdx.x;
  {
    const long total = (long)MP * 256;
    for (long i = (long)bid * 256 + tid; i < total; i += (long)nb * 256) {
      int row = (int)(i >> 8), c4 = (int)(i & 255);
      float4 v = make_float4(0.f, 0.f, 0.f, 0.f);
      if (row < T) v = ((const float4*)p.x_prompt)[(long)row * 256 + c4];
      else if (row < MT) v = ((const float4*)p.x_sample)[(long)(row - T) * 256 + c4];
      else if (row < MX) v = ((const float4*)p.state_shift)[(long)(row - MT) * 256 + c4];
      ushort4 o;
      o.x = f2bf(v.x); o.y = f2bf(v.y); o.z = f2bf(v.z); o.w = f2bf(v.w);
      ((ushort4*)p.Xb)[i] = o;
    }
  }
  {
    const int n0 = 16 * 58, n1 = n0 + 16 * 16, n2 = n1 + 16 * 80, n3 = n2 + 8 * 16;
    for (int t = bid; t < n3; t += nb) {
      if (t < n0) transpose_tile(p.w_in_even, p.WinE, 1024, EC, t % 16, t / 16, (float*)smem);
      else if (t < n1) transpose_tile(p.w_out_even, p.WoutE, 1024, 1024, (t - n0) % 16, (t - n0) / 16, (float*)smem);
      else if (t < n2) transpose_tile(p.w_in_odd, p.WinO, 1024, OC, (t - n1) % 16, (t - n1) / 16, (float*)smem);
      else transpose_tile(p.w_out_odd, p.WoutO, 512, 1024, (t - n2) % 8, (t - n2) / 8, (float*)smem);
    }
  }
  for (int i = bid * 256 + tid; i < 30 * 512; i += nb * 256) p.U[i - 30 * 512] = 0.f;
  for (int i = bid * 256 + tid; i < 1024 + 32 * 1024; i += nb * 256) {
    if (i < 1024) p.shift_p[i] = p.x_prompt[(long)(T - 1) * 1024 + i];
    else {
      int q = i - 1024, b = q >> 10, c = q & 1023;
      p.shift_s[q] = p.x_sample[(long)(b * 4 + 3) * 1024 + c];
    }
  }
}

DEVI int qs_perm(int t, int g) {
  const int lg = g * 2;
  return t < T ? (t & ((1 << lg) - 1)) * (T >> lg) + (t >> lg) : t;
}
DEVI long qs_off(int sec, int row) { return ((long)sec * MP + row) * 512; }
template <int EPI>
__device__ void gemm_phase(const u16* __restrict__ A, const u16* __restrict__ Bt, int K, int nM, int nN,
                           float* __restrict__ C, int ldc, const float* __restrict__ res0,
                           const float* __restrict__ res1, int bid, int nb, char* smem) {
  u16* sA = (u16*)smem;
  u16* sB = sA + 2 * 5120;
  const int tid = threadIdx.x, lane = tid & 63, w = tid >> 6, wm = w >> 1, wn = w & 1;
  const int lr = lane & 15, lq = lane >> 4;
  const int ntiles = nM * nN, nk = K / 32;
  const int r0 = tid >> 2, kc = tid & 3;
  const int so0 = r0 * 40 + kc * 8, so1 = so0 + 64 * 40;
  for (int tile = bid; tile < ntiles; tile += nb) {
    int nig = 8 * nN, gid = tile / nig, fm = gid * 8, gsz = min(nM - fm, 8);
    int tm = fm + ((tile % nig) % gsz), tn = (tile % nig) / gsz;
    const u16* a0p = A + (long)(tm * 128 + r0) * K + kc * 8;
    const u16* a1p = a0p + 64L * K;
    const u16* b0p = Bt + (long)(tn * 128 + r0) * K + kc * 8;
    const u16* b1p = b0p + 64L * K;
    uint4 ea0 = *(const uint4*)a0p, ea1 = *(const uint4*)a1p, eb0 = *(const uint4*)b0p, eb1 = *(const uint4*)b1p;
    uint4 oa0 = *(const uint4*)(a0p + 32), oa1 = *(const uint4*)(a1p + 32), ob0 = *(const uint4*)(b0p + 32),
          ob1 = *(const uint4*)(b1p + 32);
    f32x4 acc[4][4];
#pragma unroll
    for (int mi = 0; mi < 4; ++mi)
#pragma unroll
      for (int ni = 0; ni < 4; ++ni) acc[mi][ni] = (f32x4){0.f, 0.f, 0.f, 0.f};
    __syncthreads();
    *(uint4*)&sA[so0] = ea0; *(uint4*)&sA[so1] = ea1; *(uint4*)&sB[so0] = eb0; *(uint4*)&sB[so1] = eb1;
    __syncthreads();
    auto compute = [&](int buf) {
      const u16* cA = sA + buf * 5120;
      const u16* cB = sB + buf * 5120;
      bf16x8 af[4], bfr[4];
#pragma unroll
      for (int mi = 0; mi < 4; ++mi) af[mi] = *(const bf16x8*)&cA[(wm * 64 + mi * 16 + lr) * 40 + lq * 8];
#pragma unroll
      for (int ni = 0; ni < 4; ++ni) bfr[ni] = *(const bf16x8*)&cB[(wn * 64 + ni * 16 + lr) * 40 + lq * 8];
#pragma unroll
      for (int mi = 0; mi < 4; ++mi)
#pragma unroll
        for (int ni = 0; ni < 4; ++ni)
          acc[mi][ni] = __builtin_amdgcn_mfma_f32_16x16x32_bf16(af[mi], bfr[ni], acc[mi][ni], 0, 0, 0);
    };
    for (int kt = 0; kt < nk; kt += 2) {
      {
        const int kn = min(kt + 2, nk - 1) * 32;
        ea0 = *(const uint4*)(a0p + kn); ea1 = *(const uint4*)(a1p + kn);
        eb0 = *(const uint4*)(b0p + kn); eb1 = *(const uint4*)(b1p + kn);
      }
      __builtin_amdgcn_sched_barrier(0);
      compute(0);
      __builtin_amdgcn_sched_barrier(0);
      *(uint4*)&sA[5120 + so0] = oa0; *(uint4*)&sA[5120 + so1] = oa1;
      *(uint4*)&sB[5120 + so0] = ob0; *(uint4*)&sB[5120 + so1] = ob1;
      __syncthreads();
      {
        const int kn = min(kt + 3, nk - 1) * 32;
        oa0 = *(const uint4*)(a0p + kn); oa1 = *(const uint4*)(a1p + kn);
        ob0 = *(const uint4*)(b0p + kn); ob1 = *(const uint4*)(b1p + kn);
      }
      __builtin_amdgcn_sched_barrier(0);
      compute(1);
      __builtin_amdgcn_sched_barrier(0);
      *(uint4*)&sA[so0] = ea0; *(uint4*)&sA[so1] = ea1; *(uint4*)&sB[so0] = eb0; *(uint4*)&sB[so1] = eb1;
      __syncthreads();
    }
#pragma unroll
    for (int mi = 0; mi < 4; ++mi) {
#pragma unroll
      for (int j = 0; j < 4; ++j) {
        const int row = tm * 128 + wm * 64 + mi * 16 + lq * 4 + j;
        const int col = tn * 128 + wn * 64 + lr;
        float* cp = C + (long)row * ldc + col;
        if (EPI == 2) {
          u16* cb = (u16*)C + (long)row * ldc + col;
          const float sc = (tn * 128 < 1536) ? 0.125f : 1.f;
#pragma unroll
          for (int ni = 0; ni < 4; ++ni) cb[ni * 16] = f2bf(acc[mi][ni][j] * sc);
        } else if (EPI == 1) {
          const float* rp = (row < T ? res0 + (long)row * 1024 : res1 + (long)(row - T) * 1024) + col;
#pragma unroll
          for (int ni = 0; ni < 4; ++ni) cp[ni * 16] = acc[mi][ni][j] + ALPHA * rp[ni * 16];
        } else {
#pragma unroll
          for (int ni = 0; ni < 4; ++ni) cp[ni * 16] = acc[mi][ni][j];
        }
      }
      asm volatile("" ::: "memory");
    }
  }
}

template <int EPI>
__device__ void gemm_big(const u16* __restrict__ A, const u16* __restrict__ Bt, int K, int nM, int nN,
                         float* __restrict__ C, int ldc, int bid, int nb, char* smem) {
  u16* sA = (u16*)smem;
  u16* sB = sA + 2 * 10240;
  const int tid = threadIdx.x, lane = tid & 63, w = tid >> 6, wm = w >> 1, wn = w & 1;
  const int lr = lane & 15, lq = lane >> 4;
  const int ntiles = nM * nN, nk = K / 32;
  const int r0 = tid >> 2, kc = tid & 3;
  const int so = r0 * 40 + kc * 8;
  for (int tile = bid; tile < ntiles; tile += nb) {
    int nig = 8 * nN, gid = tile / nig, fm = gid * 8, gsz = min(nM - fm, 8);
    int tm = fm + ((tile % nig) % gsz), tn = (tile % nig) / gsz;
    const u16* ap = A + (long)(tm * 256 + r0) * K + kc * 8;
    const u16* bp = Bt + (long)(tn * 128 + r0) * K + kc * 8;
    uint4 ra0 = *(const uint4*)ap, ra1 = *(const uint4*)(ap + 64L * K), ra2 = *(const uint4*)(ap + 128L * K),
          ra3 = *(const uint4*)(ap + 192L * K);
    uint4 rb0 = *(const uint4*)bp, rb1 = *(const uint4*)(bp + 64L * K);
    f32x4 acc[8][4];
#pragma unroll
    for (int mi = 0; mi < 8; ++mi)
#pragma unroll
      for (int ni = 0; ni < 4; ++ni) acc[mi][ni] = (f32x4){0.f, 0.f, 0.f, 0.f};
    __syncthreads();
    *(uint4*)&sA[so] = ra0; *(uint4*)&sA[so + 2560] = ra1; *(uint4*)&sA[so + 5120] = ra2; *(uint4*)&sA[so + 7680] = ra3;
    *(uint4*)&sB[so] = rb0; *(uint4*)&sB[so + 2560] = rb1;
    __syncthreads();
    for (int kt = 0; kt < nk; ++kt) {
      const int buf = kt & 1;
      {
        const int kn = min(kt + 1, nk - 1) * 32;
        ra0 = *(const uint4*)(ap + kn); ra1 = *(const uint4*)(ap + 64L * K + kn);
        ra2 = *(const uint4*)(ap + 128L * K + kn); ra3 = *(const uint4*)(ap + 192L * K + kn);
        rb0 = *(const uint4*)(bp + kn); rb1 = *(const uint4*)(bp + 64L * K + kn);
      }
      __builtin_amdgcn_sched_barrier(0);
      const u16* cA = sA + buf * 10240;
      const u16* cB = sB + buf * 5120;
      bf16x8 bfr[4];
#pragma unroll
      for (int ni = 0; ni < 4; ++ni) bfr[ni] = *(const bf16x8*)&cB[(wn * 64 + ni * 16 + lr) * 40 + lq * 8];
#pragma unroll
      for (int mi = 0; mi < 8; ++mi) {
        const bf16x8 af = *(const bf16x8*)&cA[(wm * 128 + mi * 16 + lr) * 40 + lq * 8];
#pragma unroll
        for (int ni = 0; ni < 4; ++ni)
          acc[mi][ni] = __builtin_amdgcn_mfma_f32_16x16x32_bf16(af, bfr[ni], acc[mi][ni], 0, 0, 0);
      }
      __builtin_amdgcn_sched_barrier(0);
      {
        u16* nA = sA + (buf ^ 1) * 10240;
        u16* nB = sB + (buf ^ 1) * 5120;
        *(uint4*)&nA[so] = ra0; *(uint4*)&nA[so + 2560] = ra1; *(uint4*)&nA[so + 5120] = ra2; *(uint4*)&nA[so + 7680] = ra3;
        *(uint4*)&nB[so] = rb0; *(uint4*)&nB[so + 2560] = rb1;
      }
      __syncthreads();
    }
#pragma unroll
    for (int mi = 0; mi < 8; ++mi) {
#pragma unroll
      for (int j = 0; j < 4; ++j) {
        const int row = tm * 256 + wm * 128 + mi * 16 + lq * 4 + j;
        const int col = tn * 128 + wn * 64 + lr;
        if (EPI == 2) {
          const int sec = tn >> 2;
          const int orow = sec < 9 ? qs_perm(row, sec % 3) : row;
          u16* cb = (u16*)C + qs_off(sec, orow) + (tn & 3) * 128 + wn * 64 + lr;
          const float sc = (tn * 128 < 1536) ? 0.125f : 1.f;
#pragma unroll
          for (int ni = 0; ni < 4; ++ni) cb[ni * 16] = f2bf(acc[mi][ni][j] * sc);
        } else {
          float* cp = C + (long)row * ldc + col;
#pragma unroll
          for (int ni = 0; ni < 4; ++ni) cp[ni * 16] = acc[mi][ni][j];
        }
      }
      asm volatile("" ::: "memory");
    }
  }
}

__device__ void phaseC(const Params& p, int bid, int nb, char* smem) {
  float* lwd = (float*)smem;
  float* lad = lwd + 256;
  const int tid = threadIdx.x;
  const float* __restrict__ P = p.P;
#pragma unroll 1
  for (int half = 0; half < 2; ++half) {
    const int c = tid + half * 256;
    float w2c[32], a2c[32];
#pragma unroll
    for (int l = 0; l < 32; ++l) { w2c[l] = p.w2[l * 512 + c]; a2c[l] = p.a2[l * 512 + c]; }
    const float w0c = p.w0[c], a0c = p.a0[c];
    const float mur = p.mu[c], muk = p.mu[512 + c], muv = p.mu[1024 + c];
    const float kkc = p.k_k[c], kac = p.k_a[c];
    const float mwa = p.mu[1536 + (tid & 63)];
    for (int it = bid; it < MT / 8; it += nb) {
      const int row0 = it * 8;
      __syncthreads();
#pragma unroll
      for (int e = tid; e < 512; e += 256) {
        int r = e >> 6, cc = e & 63;
        int row = row0 + r, prow = prev_row(row);
        float cur = P[(long)row * ECP + 1536 + cc];
        float prv = prow >= 0 ? P[(long)prow * ECP + 1536 + cc] : 0.f;
        float val = cur + (prv - cur) * mwa;
        if (cc < 32) lwd[r * 32 + cc] = 1.f - 2.f * frcp(1.f + __expf(2.f * val));
        else lad[r * 32 + cc - 32] = val;
      }
      __syncthreads();
      float cum = 1.f;
#pragma unroll 4
      for (int r = 0; r < 8; ++r) {
        const int row = row0 + r, prow = prev_row(row);
        const float* pc = P + (long)row * ECP;
        const float cr = pc[c], ck = pc[512 + c], cv = pc[1024 + c], cval = pc[1600 + c], cglu = pc[2112 + c];
        float pr = 0.f, pk = 0.f, pv = 0.f;
        if (prow >= 0) { const float* pp = P + (long)prow * ECP; pr = pp[c]; pk = pp[512 + c]; pv = pp[1024 + c]; }
        float aw = w0c, aa = a0c;
#pragma unroll
        for (int l4 = 0; l4 < 8; ++l4) {
          const float4 x = *(const float4*)&lwd[r * 32 + l4 * 4];
          const float4 y = *(const float4*)&lad[r * 32 + l4 * 4];
          aw += x.x * w2c[l4 * 4] + x.y * w2c[l4 * 4 + 1] + x.z * w2c[l4 * 4 + 2] + x.w * w2c[l4 * 4 + 3];
          aa += y.x * a2c[l4 * 4] + y.y * a2c[l4 * 4 + 1] + y.z * a2c[l4 * 4 + 2] + y.w * a2c[l4 * 4 + 3];
        }
        float rr = cr + (pr - cr) * mur, kx = ck + (pk - ck) * muk, vv = cv + (pv - cv) * muv;
        float z = -aw;
        float sp = fmaxf(z, 0.f) + __logf(1.f + __expf(-fabsf(z)));
        float decay = __expf(-__expf(-sp - 0.5f));
        float a = sigmoidf_(aa);
        float kkv = kx * kkc;
        float ss = wave_sum(kkv * kkv);
        kkv = kkv * fminf(__builtin_amdgcn_rsqf(ss), 1e12f);
        float kmod = kx * (1.f + (a - 1.f) * kac);
        const float cprev = (r == 0 || (r == 4 && row0 >= T)) ? 1.f : cum;
        cum = cprev * decay;
        const float cinv = frcp(cum);
        float* so = p.scan + (long)row * 3072 + c;
        so[0] = rr * cum;
        so[512] = cum;
        so[1024] = kmod * cinv;
        so[1536] = vv;
        so[2048] = kkv * cprev;
        so[2560] = -(kkv * a) * cinv;
        p.U[(long)row * 512 + c] = cval * sigmoidf_(cglu);
      }
    }
  }
}

typedef float f2 __attribute__((ext_vector_type(2)));
constexpr int CH = 128;
constexpr int NCH = T / CH;
DEVI float row8_sum(float x) {
  x += dppf<0x141>(x);
  x += dppf<0x4E>(x);
  x += dppf<0xB1>(x);
  return x;
}
template <int R, bool P1>
__device__ void scan_chunk(const Params& p, int h, int row0, int nsteps, const float* __restrict__ init,
                           float* __restrict__ fin0, float* __restrict__ fin1, char* smem) {
  constexpr bool OUT = !P1;
  float* buf = (float*)smem;
  const int tid = threadIdx.x, lane = tid & 63, w = tid >> 6, cg = lane & 7, rg = lane >> 3;
  const int rowb = w * 8 * R + rg * R, j0 = cg * 8;
  const bool isG = P1 && (rowb >= 64);
  const int ib = rowb & 63;
  f2 S[R][4];
#pragma unroll
  for (int rr = 0; rr < R; ++rr) {
    if (!P1) {
      float4 t0 = *(const float4*)(init + (ib + rr) * 64 + j0), t1 = *(const float4*)(init + (ib + rr) * 64 + j0 + 4);
      S[rr][0] = (f2){t0.x, t0.y}; S[rr][1] = (f2){t0.z, t0.w};
      S[rr][2] = (f2){t1.x, t1.y}; S[rr][3] = (f2){t1.z, t1.w};
    } else {
      int d = isG ? ib + rr - j0 : -1;
#pragma unroll
      for (int q = 0; q < 4; ++q) S[rr][q] = (f2){d == 2 * q ? 1.f : 0.f, d == 2 * q + 1 ? 1.f : 0.f};
    }
  }
  const int nch = (nsteps + 15) >> 4;
  const float* __restrict__ sc = p.scan;
  float4 pre[6];
  __syncthreads();
#pragma unroll
  for (int q = 0; q < 6; ++q) {
    int e = tid + q * 256, st = e / 96, rem = e - st * 96, a = rem >> 4, f4 = rem & 15;
    pre[q] = make_float4(0.f, 0.f, 0.f, 0.f);
    if (st < nsteps) pre[q] = *(const float4*)(sc + (long)(row0 + st) * 3072 + a * 512 + h * 64 + f4 * 4);
  }
#pragma unroll
  for (int q = 0; q < 6; ++q) *(float4*)(buf + (tid + q * 256) * 4) = pre[q];
  __syncthreads();
  for (int c = 0; c < nch; ++c) {
    const int s0 = c * 16;
    const int n = min(16, nsteps - s0);
    if (c + 1 < nch) {
#pragma unroll
      for (int q = 0; q < 6; ++q) {
        int e = tid + q * 256, st = e / 96, rem = e - st * 96, a = rem >> 4, f4 = rem & 15;
        int gs = s0 + 16 + st;
        pre[q] = make_float4(0.f, 0.f, 0.f, 0.f);
        if (gs < nsteps) pre[q] = *(const float4*)(sc + (long)(row0 + gs) * 3072 + a * 512 + h * 64 + f4 * 4);
      }
    }
    const float* cb = buf + (c & 1) * 6144;
    for (int s = 0; s < n; ++s) {
      const float* L = cb + s * 384;
      f2 kv[4], kkv[4], nbv[4], rv[4];
      {
        const float4 a = *(const float4*)(L + 128 + j0), b = *(const float4*)(L + 128 + j0 + 4);
        kv[0] = (f2){a.x, a.y}; kv[1] = (f2){a.z, a.w}; kv[2] = (f2){b.x, b.y}; kv[3] = (f2){b.z, b.w};
      }
      {
        const float4 a = *(const float4*)(L + 256 + j0), b = *(const float4*)(L + 256 + j0 + 4);
        kkv[0] = (f2){a.x, a.y}; kkv[1] = (f2){a.z, a.w}; kkv[2] = (f2){b.x, b.y}; kkv[3] = (f2){b.z, b.w};
      }
      {
        const float4 a = *(const float4*)(L + 320 + j0), b = *(const float4*)(L + 320 + j0 + 4);
        nbv[0] = (f2){a.x, a.y}; nbv[1] = (f2){a.z, a.w}; nbv[2] = (f2){b.x, b.y}; nbv[3] = (f2){b.z, b.w};
      }
      if (OUT) {
        const float4 a = *(const float4*)(L + j0), b = *(const float4*)(L + j0 + 4);
        rv[0] = (f2){a.x, a.y}; rv[1] = (f2){a.z, a.w}; rv[2] = (f2){b.x, b.y}; rv[3] = (f2){b.z, b.w};
      }
      float vi[R];
      if (R == 4) {
        const float4 t = *(const float4*)(L + 192 + ib);
        vi[0] = t.x; vi[1] = t.y; vi[2] = t.z; vi[R - 1] = t.w;
      } else {
        const float2 t = *(const float2*)(L + 192 + ib);
        vi[0] = t.x; vi[1] = t.y;
      }
      float o[R], sum[R];
      f2 t[R];
#pragma unroll
      for (int rr = 0; rr < R; ++rr) t[rr] = S[rr][0] * kkv[0];
#pragma unroll
      for (int rr = 0; rr < R; ++rr) t[rr] = __builtin_elementwise_fma(S[rr][1], kkv[1], t[rr]);
#pragma unroll
      for (int rr = 0; rr < R; ++rr) t[rr] = __builtin_elementwise_fma(S[rr][2], kkv[2], t[rr]);
#pragma unroll
      for (int rr = 0; rr < R; ++rr) t[rr] = __builtin_elementwise_fma(S[rr][3], kkv[3], t[rr]);
#pragma unroll
      for (int rr = 0; rr < R; ++rr) sum[rr] = t[rr].x + t[rr].y;
#pragma unroll
      for (int rr = 0; rr < R; ++rr) sum[rr] += dppf<0x141>(sum[rr]);
#pragma unroll
      for (int rr = 0; rr < R; ++rr) sum[rr] += dppf<0x4E>(sum[rr]);
#pragma unroll
      for (int rr = 0; rr < R; ++rr) sum[rr] += dppf<0xB1>(sum[rr]);
      if (isG) {
#pragma unroll
        for (int q = 0; q < 4; ++q)
#pragma unroll
          for (int rr = 0; rr < R; ++rr) S[rr][q] = __builtin_elementwise_fma(nbv[q], (f2){sum[rr], sum[rr]}, S[rr][q]);
      } else {
#pragma unroll
        for (int q = 0; q < 4; ++q)
#pragma unroll
          for (int rr = 0; rr < R; ++rr)
            S[rr][q] = __builtin_elementwise_fma(kv[q], (f2){vi[rr], vi[rr]}, __builtin_elementwise_fma(nbv[q], (f2){sum[rr], sum[rr]}, S[rr][q]));
      }
      if (OUT) {
#pragma unroll
        for (int rr = 0; rr < R; ++rr) t[rr] = S[rr][0] * rv[0];
#pragma unroll
        for (int rr = 0; rr < R; ++rr) t[rr] = __builtin_elementwise_fma(S[rr][1], rv[1], t[rr]);
#pragma unroll
        for (int rr = 0; rr < R; ++rr) t[rr] = __builtin_elementwise_fma(S[rr][2], rv[2], t[rr]);
#pragma unroll
        for (int rr = 0; rr < R; ++rr) t[rr] = __builtin_elementwise_fma(S[rr][3], rv[3], t[rr]);
#pragma unroll
        for (int rr = 0; rr < R; ++rr) o[rr] = t[rr].x + t[rr].y;
#pragma unroll
        for (int rr = 0; rr < R; ++rr) o[rr] += dppf<0x141>(o[rr]);
#pragma unroll
        for (int rr = 0; rr < R; ++rr) o[rr] += dppf<0x4E>(o[rr]);
#pragma unroll
        for (int rr = 0; rr < R; ++rr) o[rr] += dppf<0xB1>(o[rr]);
      }
      if ((s & 7) == 7 || s == n - 1) {
        const float4 a = *(const float4*)(L + 64 + j0), b = *(const float4*)(L + 64 + j0 + 4);
        const f2 c0 = {a.x, a.y}, c1 = {a.z, a.w}, c2 = {b.x, b.y}, c3 = {b.z, b.w};
#pragma unroll
        for (int rr = 0; rr < R; ++rr) { S[rr][0] *= c0; S[rr][1] *= c1; S[rr][2] *= c2; S[rr][3] *= c3; }
      }
      if (OUT && cg == 0) {
        float* op = buf + 12288 + s * 64 + ib;
        if (R == 4) *(float4*)op = make_float4(o[0], o[1], o[2], o[R - 1]);
        else *(float2*)op = make_float2(o[0], o[1]);
      }
    }
    if (OUT) {
      __syncthreads();
      const int tk = tid >> 4, ch = (tid & 15) * 4;
      if (tk < n) {
        const float4 o4 = *(const float4*)(buf + 12288 + tk * 64 + ch);
        const float mean = row16_sum(o4.x + o4.y + o4.z + o4.w) * (1.f / 64.f);
        const float d0 = o4.x - mean, d1 = o4.y - mean, d2 = o4.z - mean, d3 = o4.w - mean;
        const float rstd = rsqrtf(row16_sum(d0 * d0 + d1 * d1 + d2 * d2 + d3 * d3) * (1.f / 64.f) + 64e-5f);
        const float* L = cb + tk * 384;
        const float4 r4 = *(const float4*)(L + ch), k4 = *(const float4*)(L + 128 + ch), v4 = *(const float4*)(L + 192 + ch);
        const float4 rk4 = *(const float4*)(p.r_k + h * 64 + ch);
        const float4 lg = *(const float4*)(p.lnx_g + h * 64 + ch), lb = *(const float4*)(p.lnx_b + h * 64 + ch);
        const float bsum = row16_sum(r4.x * k4.x * rk4.x + r4.y * k4.y * rk4.y + r4.z * k4.z * rk4.z + r4.w * k4.w * rk4.w);
        const long row = row0 + s0 + tk;
        const float4 gt = *(const float4*)(p.P + row * ECP + 3136 + h * 64 + ch);
        ushort4 ob;
        ob.x = f2bf((d0 * rstd * lg.x + lb.x + bsum * v4.x) * siluf_(gt.x));
        ob.y = f2bf((d1 * rstd * lg.y + lb.y + bsum * v4.y) * siluf_(gt.y));
        ob.z = f2bf((d2 * rstd * lg.z + lb.z + bsum * v4.z) * siluf_(gt.z));
        ob.w = f2bf((d3 * rstd * lg.w + lb.w + bsum * v4.w) * siluf_(gt.w));
        *(ushort4*)(p.Y + row * 1024 + 512 + h * 64 + ch) = ob;
      }
    }
    if (c + 1 < nch) {
      float* nbuf = buf + ((c + 1) & 1) * 6144;
#pragma unroll
      for (int q = 0; q < 6; ++q) *(float4*)(nbuf + (tid + q * 256) * 4) = pre[q];
    }
    __syncthreads();
  }
  float* fin = isG ? fin1 : fin0;
  if (fin) {
#pragma unroll
    for (int rr = 0; rr < R; ++rr) {
      *(float4*)(fin + (ib + rr) * 64 + j0) = make_float4(S[rr][0].x, S[rr][0].y, S[rr][1].x, S[rr][1].y);
      *(float4*)(fin + (ib + rr) * 64 + j0 + 4) = make_float4(S[rr][2].x, S[rr][2].y, S[rr][3].x, S[rr][3].y);
    }
  }
}

__device__ void scan_pass2(const Params& p, int item, char* smem) {
  float* sS = (float*)smem;
  float* red = sS + 512;
  const int tid = threadIdx.x, q = tid >> 6, j = tid & 63;
  const int h = item >> 3, i0 = (item & 7) * 8;
  const int oi = tid >> 5, oj = (tid & 31) * 2;
  float s0 = 0.f, s1 = 0.f;
  float g[16], gn[16];
  const float* Gh = p.Gbuf + (long)h * NCH * 4096;
  const float* Hh = p.Hbuf + (long)h * NCH * 4096;
  float* Sh = p.Sst + (long)h * NCH * 4096;
#pragma unroll
  for (int u = 0; u < 16; ++u) g[u] = Gh[(q * 16 + u) * 64 + j];
  float2 hv = *(const float2*)(Hh + (i0 + oi) * 64 + oj), hn = hv;
  __syncthreads();
  for (int c = 0; c < NCH; ++c) {
    *(float2*)(Sh + (long)c * 4096 + (i0 + oi) * 64 + oj) = make_float2(s0, s1);
    sS[oj * 8 + oi] = s0;
    sS[(oj + 1) * 8 + oi] = s1;
    __syncthreads();
    if (c + 1 < NCH) {
#pragma unroll
      for (int u = 0; u < 16; ++u) gn[u] = Gh[(long)(c + 1) * 4096 + (q * 16 + u) * 64 + j];
      hn = *(const float2*)(Hh + (long)(c + 1) * 4096 + (i0 + oi) * 64 + oj);
    }
    float acc[8];
#pragma unroll
    for (int i = 0; i < 8; ++i) acc[i] = 0.f;
#pragma unroll
    for (int u = 0; u < 16; ++u) {
      const int jp = q * 16 + u;
      const float4 sa = *(const float4*)(sS + jp * 8), sb = *(const float4*)(sS + jp * 8 + 4);
      acc[0] += sa.x * g[u]; acc[1] += sa.y * g[u]; acc[2] += sa.z * g[u]; acc[3] += sa.w * g[u];
      acc[4] += sb.x * g[u]; acc[5] += sb.y * g[u]; acc[6] += sb.z * g[u]; acc[7] += sb.w * g[u];
    }
#pragma unroll
    for (int i = 0; i < 8; ++i) red[(q * 8 + i) * 64 + j] = acc[i];
    __syncthreads();
    s0 = hv.x; s1 = hv.y;
    hv = hn;
#pragma unroll
    for (int qq = 0; qq < 4; ++qq) {
      const float2 rv = *(const float2*)(red + (qq * 8 + oi) * 64 + oj);
      s0 += rv.x; s1 += rv.y;
    }
#pragma unroll
    for (int u = 0; u < 16; ++u) g[u] = gn[u];
  }
  *(float2*)(p.wkv_p + h * 4096 + (i0 + oi) * 64 + oj) = make_float2(s0, s1);
}

DEVI void conv1(const Params& p, int row0, int ch, float (&a)[4]) {
  const bool prm = row0 < T;
  const int bb = (row0 - T) >> 2;
  const float* pb = p.U + (long)(row0 - 30) * 512 + ch;
  const float* pa = prm ? pb : p.state_conv + (long)(bb * 30) * 512 + ch;
  float u[34];
#pragma unroll
  for (int e = 0; e < 34; ++e) u[e] = (e < 30 ? pa : pb)[e * 512];
  const float cb0 = p.conv_b[ch];
#pragma unroll
  for (int r = 0; r < 4; ++r) a[r] = cb0;
#pragma unroll
  for (int j = 0; j < 31; ++j) {
    const float w0 = p.conv_w[j * 512 + ch];
#pragma unroll
    for (int r = 0; r < 4; ++r) a[r] += w0 * u[j + r];
  }
}
__device__ void conv_wave_item(const Params& p, int grp, float* cbuf  ) {
  const int lane = threadIdx.x & 63;
  const int row0 = grp * 4;
  float s0 = 0.f, s1 = 0.f, s2 = 0.f, s3 = 0.f;
#pragma unroll 1
  for (int c = 0; c < 8; ++c) {
    float a[4];
    conv1(p, row0, c * 64 + lane, a);
    s0 += a[0]; s1 += a[1]; s2 += a[2]; s3 += a[3];
    cbuf[(c * 4 + 0) * 64 + lane] = a[0]; cbuf[(c * 4 + 1) * 64 + lane] = a[1];
    cbuf[(c * 4 + 2) * 64 + lane] = a[2]; cbuf[(c * 4 + 3) * 64 + lane] = a[3];
  }
  const float m0 = wave_sum(s0) * (1.f / 512.f), m1 = wave_sum(s1) * (1.f / 512.f), m2 = wave_sum(s2) * (1.f / 512.f),
              m3 = wave_sum(s3) * (1.f / 512.f);
  float q0 = 0.f, q1 = 0.f, q2 = 0.f, q3 = 0.f;
#pragma unroll
  for (int c = 0; c < 8; ++c) {
    const float d0 = cbuf[(c * 4 + 0) * 64 + lane] - m0, d1 = cbuf[(c * 4 + 1) * 64 + lane] - m1,
                d2 = cbuf[(c * 4 + 2) * 64 + lane] - m2, d3 = cbuf[(c * 4 + 3) * 64 + lane] - m3;
    q0 += d0 * d0; q1 += d1 * d1; q2 += d2 * d2; q3 += d3 * d3;
  }
  const float r0 = rsqrtf(wave_sum(q0) * (1.f / 512.f) + 1e-5f), r1 = rsqrtf(wave_sum(q1) * (1.f / 512.f) + 1e-5f),
              r2 = rsqrtf(wave_sum(q2) * (1.f / 512.f) + 1e-5f), r3 = rsqrtf(wave_sum(q3) * (1.f / 512.f) + 1e-5f);
#pragma unroll 2
  for (int c = 0; c < 8; ++c) {
    const int ch = c * 64 + lane;
    const float lg = p.cln_g[ch], lb = p.cln_b[ch];
    const float y0 = (cbuf[(c * 4 + 0) * 64 + lane] - m0) * r0 * lg + lb, y1 = (cbuf[(c * 4 + 1) * 64 + lane] - m1) * r1 * lg + lb,
                y2 = (cbuf[(c * 4 + 2) * 64 + lane] - m2) * r2 * lg + lb, y3 = (cbuf[(c * 4 + 3) * 64 + lane] - m3) * r3 * lg + lb;
    const float g0 = p.P[(long)(row0 + 0) * ECP + 2624 + ch], g1 = p.P[(long)(row0 + 1) * ECP + 2624 + ch],
                g2 = p.P[(long)(row0 + 2) * ECP + 2624 + ch], g3 = p.P[(long)(row0 + 3) * ECP + 2624 + ch];
    p.Y[(long)(row0 + 0) * 1024 + ch] = f2bf(siluf_(y0) * siluf_(g0));
    p.Y[(long)(row0 + 1) * 1024 + ch] = f2bf(siluf_(y1) * siluf_(g1));
    p.Y[(long)(row0 + 2) * 1024 + ch] = f2bf(siluf_(y2) * siluf_(g2));
    p.Y[(long)(row0 + 3) * 1024 + ch] = f2bf(siluf_(y3) * siluf_(g3));
  }
}

__device__ void phaseD1(const Params& p, int bid, int nb, char* smem) {
  for (int it = bid; it < 8 * NCH; it += nb) {
    const int h = it / NCH, c = it - h * NCH;
    scan_chunk<4, true>(p, h, c * CH, CH, nullptr, p.Hbuf + (long)it * 4096, p.Gbuf + (long)it * 4096, smem);
  }
  for (int it = bid; it < 256; it += nb) {
    const int b = it >> 3, h = it & 7;
    scan_chunk<2, false>(p, h, T + b * 4, 4, p.state_wkv + (long)it * 4096, p.wkv_s + (long)it * 4096, nullptr, smem);
  }
  __syncthreads();
  for (int g = bid * 4 + (threadIdx.x >> 6); g < MT / 4; g += nb * 4) conv_wave_item(p, g, (float*)smem + (threadIdx.x >> 6) * 2048);
}
__device__ void phaseD2(const Params& p, int bid, int nb, char* smem) {
  if (bid < 64) { scan_pass2(p, bid, smem); return; }
  copy_cache<128>(p.cache0, p.kvs0, bid - 64, nb - 64);
  copy_cache<512>(p.cache1, p.kvs1, bid - 64, nb - 64);
  copy_cache<2048>(p.cache2, p.kvs2, bid - 64, nb - 64);
}
__device__ void phaseD3(const Params& p, int bid, int nb, char* smem) {
  for (int it = bid; it < 8 * NCH; it += nb) {
    const int h = it / NCH, c = it - h * NCH;
    scan_chunk<2, false>(p, h, c * CH, CH, p.Sst + (long)it * 4096, nullptr, nullptr, smem);
  }
}

__device__ void conv_state_out(const Params& p, int bid, int nb) {
  for (int i = bid * 256 + threadIdx.x; i < 15360 + 491520; i += nb * 256) {
    if (i < 15360) p.conv_p[i] = p.U[(long)(T - 30) * 512 + i];
    else {
      int q = i - 15360, b = q / 15360, rem = q - b * 15360, r = rem >> 9, ch = rem & 511;
      p.conv_s[q] = r < 26 ? p.state_conv[(long)(b * 30 + r + 4) * 512 + ch] : p.U[(long)(T + b * 4 + r - 26) * 512 + ch];
    }
  }
}

__device__ void ln_phase(const float* __restrict__ Z, const float* res0, const float* res1,
                         const float* __restrict__ g, const float* __restrict__ bta,
                         float* out0, float* out1, u16* outb, int bid, int nb) {
  const int lane = threadIdx.x & 63, w = threadIdx.x >> 6;
  for (int row = bid * 4 + w; row < MT; row += nb * 4) {
    const float4* z4 = (const float4*)(Z + (long)row * 1024);
    float4 v[4];
    float s = 0.f;
    const float4* r4 =(const float4*)(row < T ? res0 + (long)row * 1024 : res1 + (long)(row - T) * 1024);
#pragma unroll
    for (int i = 0; i < 4; ++i) {
      float4 z = z4[lane + i * 64], r = r4[lane + i * 64];
      v[i].x = z.x + ALPHA * r.x; v[i].y = z.y + ALPHA * r.y; v[i].z = z.z + ALPHA * r.z; v[i].w = z.w + ALPHA * r.w;
      s += v[i].x + v[i].y + v[i].z + v[i].w;
    }
    float mean = wave_sum(s) * (1.f / 1024.f);
    float q = 0.f;
#pragma unroll
    for (int i = 0; i < 4; ++i) {
      float a = v[i].x - mean, b = v[i].y - mean, c = v[i].z - mean, d = v[i].w - mean;
      q += a * a + b * b + c * c + d * d;
    }
    float rstd = rsqrtf(wave_sum(q) * (1.f / 1024.f) + 1e-5f);
    float* op = row < T ? out0 + (long)row * 1024 : out1 + (long)(row - T) * 1024;
#pragma unroll
    for (int i = 0; i < 4; ++i) {
      float4 gg = ((const float4*)g)[lane + i * 64], bb = ((const float4*)bta)[lane + i * 64];
      float4 o;
      o.x = (v[i].x - mean) * rstd * gg.x + bb.x;
      o.y = (v[i].y - mean) * rstd * gg.y + bb.y;
      o.z = (v[i].z - mean) * rstd * gg.z + bb.z;
      o.w = (v[i].w - mean) * rstd * gg.w + bb.w;
      ((float4*)op)[lane + i * 64] = o;
      if (outb) {
        ushort4 ob;
        ob.x = f2bf(o.x); ob.y = f2bf(o.y); ob.z = f2bf(o.z); ob.w = f2bf(o.w);
        ((ushort4*)(outb + (long)row * 1024))[lane + i * 64] = ob;
      }
    }
  }
}

DEVI float bf2f(u16 v) { return __uint_as_float((unsigned)v << 16); }
struct AttnItem { int g, dil, h, c, l0, qoff; long rbase; };
DEVI AttnItem attn_decode(int item) {
  AttnItem a;
  a.g = item >> 11;
  const int rem = item & 2047;
  a.dil = a.g == 0 ? 1 : (a.g == 1 ? 4 : 16);
  const int nlb = (T / a.dil) >> 6;
  a.h = rem & 7;
  const int cl = rem >> 3;
  a.c = cl / nlb;
  a.l0 = (cl - a.c * nlb) * 64;
  a.qoff = a.g * 512 + a.h * 64;
  a.rbase = (long)a.c * (T / a.dil);
  return a;
}
DEVI void attn_load_qk(const Params& p, const AttnItem& a, uint4& rq0, uint4& rq1, uint4 (&rk)[6]) {
  const int tid = threadIdx.x;
  const u16* __restrict__ Q = p.QKVG;
  {
    const int row = tid >> 3, cc = tid & 7;
    rq0 = *(const uint4*)(Q + ((long)a.g * MP + a.rbase + a.l0 + row) * 512 + a.h * 64 + cc * 8);
    rq1 = *(const uint4*)(Q + ((long)a.g * MP + a.rbase + a.l0 + row + 32) * 512 + a.h * 64 + cc * 8);
  }
#pragma unroll
  for (int i = 0; i < 6; ++i) {
    const int ch = tid + i * 256, row = ch >> 3, cc = ch & 7;
    const int lp = a.l0 - 128 + row;
    rk[i] = make_uint4(0u, 0u, 0u, 0u);
    if (lp >= 0) rk[i] = *(const uint4*)(Q + ((long)(3 + a.g) * MP + a.rbase + lp) * 512 + a.h * 64 + cc * 8);
  }
}
DEVI void attn_load_v(const Params& p, const AttnItem& a, uint4 (&rv)[8]) {
  const int tid = threadIdx.x;
  const u16* __restrict__ Q = p.QKVG;
#pragma unroll
  for (int i = 0; i < 2; ++i) {
    const int task = tid + i * 256, kq = task >> 3, dq = task & 7;
#pragma unroll
    for (int u = 0; u < 4; ++u) {
      const int ki = kq * 4 + u, lp = a.l0 - 128 + ki;
      rv[i * 4 + u] = make_uint4(0u, 0u, 0u, 0u);
      if (task < 416 && ki < 192 && lp >= 0)
        rv[i * 4 + u] = *(const uint4*)(Q + ((long)(6 + a.g) * MP + a.rbase + lp) * 512 + a.h * 64 + dq * 8);
    }
  }
}
DEVI unsigned pk_lo(unsigned a, unsigned b) { return (a & 0xffffu) | (b << 16); }
DEVI unsigned pk_hi(unsigned a, unsigned b) { return (a >> 16) | (b & 0xffff0000u); }
DEVI void attn_store_v(u16* sVt, const uint4 (&rv)[8]) {
  const int tid = threadIdx.x;
#pragma unroll
  for (int i = 0; i < 2; ++i) {
    const int task = tid + i * 256, kq = task >> 3, dq = task & 7;
    if (task < 416) {
      const uint4 v0 = rv[i * 4], v1 = rv[i * 4 + 1], v2 = rv[i * 4 + 2], v3 = rv[i * 4 + 3];
      u16* base = sVt + (dq * 8) * 208 + kq * 4;
      *(uint2*)(base + 0 * 208) = make_uint2(pk_lo(v0.x, v1.x), pk_lo(v2.x, v3.x));
      *(uint2*)(base + 1 * 208) = make_uint2(pk_hi(v0.x, v1.x), pk_hi(v2.x, v3.x));
      *(uint2*)(base + 2 * 208) = make_uint2(pk_lo(v0.y, v1.y), pk_lo(v2.y, v3.y));
      *(uint2*)(base + 3 * 208) = make_uint2(pk_hi(v0.y, v1.y), pk_hi(v2.y, v3.y));
      *(uint2*)(base + 4 * 208) = make_uint2(pk_lo(v0.z, v1.z), pk_lo(v2.z, v3.z));
      *(uint2*)(base + 5 * 208) = make_uint2(pk_hi(v0.z, v1.z), pk_hi(v2.z, v3.z));
      *(uint2*)(base + 6 * 208) = make_uint2(pk_lo(v0.w, v1.w), pk_lo(v2.w, v3.w));
      *(uint2*)(base + 7 * 208) = make_uint2(pk_hi(v0.w, v1.w), pk_hi(v2.w, v3.w));
    }
  }
}

__device__ void attn_prompt_phase(const Params& p, int bid, int nb, char* smem) {
  u16* sQ = (u16*)smem;
  u16* sK = sQ + 64 * 72;
  u16* sVt = sK;
  u16* sP = sK + 192 * 72;
  const int tid = threadIdx.x, lane = tid & 63, w = tid >> 6, lr = lane & 15, lq = lane >> 4;
  uint4 rq0, rq1, rk[6], rv[8];
  { AttnItem a = attn_decode(min(bid, 6143)); attn_load_qk(p, a, rq0, rq1, rk); }
  for (int item = bid; item < 6144; item += nb) {
    const AttnItem a = attn_decode(item);
    __syncthreads();
    *(uint4*)&sQ[(tid >> 3) * 72 + (tid & 7) * 8] = rq0;
    *(uint4*)&sQ[((tid >> 3) + 32) * 72 + (tid & 7) * 8] = rq1;
#pragma unroll
    for (int i = 0; i < 6; ++i) { const int ch = tid + i * 256; *(uint4*)&sK[(ch >> 3) * 72 + (ch & 7) * 8] = rk[i]; }
    __syncthreads();
    attn_load_v(p, a, rv);
    bf16x8 qf[2];
    qf[0] = *(const bf16x8*)&sQ[(w * 16 + lr) * 72 + lq * 8];
    qf[1] = *(const bf16x8*)&sQ[(w * 16 + lr) * 72 + 32 + lq * 8];
    f32x4 s[9];
#pragma unroll
    for (int kt = 0; kt < 9; ++kt) {
      s[kt] = (f32x4){0.f, 0.f, 0.f, 0.f};
#pragma unroll
      for (int ks = 0; ks < 2; ++ks) {
        bf16x8 kf = *(const bf16x8*)&sK[((w + kt) * 16 + lr) * 72 + ks * 32 + lq * 8];
        s[kt] = __builtin_amdgcn_mfma_f32_16x16x32_bf16(qf[ks], kf, s[kt], 0, 0, 0);
      }
    }
    float m[4], sum[4];
#pragma unroll
    for (int j = 0; j < 4; ++j) {
      float mx = -1e30f;
#pragma unroll
      for (int kt = 0; kt < 9; ++kt) {
        int delta = lq * 4 + j + 128 - kt * 16 - lr;
        int lp = a.l0 - 128 + (w + kt) * 16 + lr;
        bool valid = (delta >= 0) && (delta <= 128) && (lp >= 0);
        float v = valid ? s[kt][j] : -1e30f;
        s[kt][j] = v;
        mx = fmaxf(mx, v);
      }
      mx = row16_max(mx);
      float sm = 0.f;
#pragma unroll
      for (int kt = 0; kt < 9; ++kt) {
        float pe = s[kt][j] > -1e29f ? __expf(s[kt][j] - mx) : 0.f;
        s[kt][j] = pe;
        sm += pe;
      }
      m[j] = mx;
      sum[j] = row16_sum(sm);
    }
    u16* wp = sP + w * 16 * 168;
#pragma unroll
    for (int j = 0; j < 4; ++j) {
#pragma unroll
      for (int kt = 0; kt < 9; ++kt) wp[(lq * 4 + j) * 168 + kt * 16 + lr] = f2bf(s[kt][j]);
      wp[(lq * 4 + j) * 168 + 144 + lr] = 0;
    }
    __syncthreads();
    attn_store_v(sVt, rv);
    { AttnItem an = attn_decode(min(item + nb, 6143)); attn_load_qk(p, an, rq0, rq1, rk); }
    __syncthreads();
    f32x4 o[4];
#pragma unroll
    for (int nt = 0; nt < 4; ++nt) o[nt] = (f32x4){0.f, 0.f, 0.f, 0.f};
#pragma unroll
    for (int ks = 0; ks < 5; ++ks) {
      bf16x8 pf = *(const bf16x8*)&wp[lr * 168 + ks * 32 + lq * 8];
#pragma unroll
      for (int nt = 0; nt < 4; ++nt) {
        bf16x8 vf = *(const bf16x8*)&sVt[(nt * 16 + lr) * 208 + w * 16 + ks * 32 + lq * 8];
        o[nt] = __builtin_amdgcn_mfma_f32_16x16x32_bf16(pf, vf, o[nt], 0, 0, 0);
      }
    }
#pragma unroll
    for (int j = 0; j < 4; ++j) {
      long t = (long)(a.l0 + w * 16 + lq * 4 + j) * a.dil + a.c;
      float inv = 1.f / sum[j];
#pragma unroll
      for (int nt = 0; nt < 4; ++nt) p.AO[((long)a.g * MT + t) * 512 + a.h * 64 + nt * 16 + lr] = o[nt][j] * inv;
      if (lr == 0) p.LSE[((long)a.g * MT + t) * 8 + a.h] = m[j] + __logf(sum[j]);
    }
  }
}

DEVI float4 us4_to_f4(ushort4 v) { return make_float4(bf2f(v.x), bf2f(v.y), bf2f(v.z), bf2f(v.w)); }
__device__ void attn_sample_item(const Params& p, int witem, float* sp) {
  const int lane = threadIdx.x & 63, l16 = lane & 15, kq = lane >> 4;
  const int h = witem & 7, g = (witem >> 3) % 3, bs = witem / 24, b = bs >> 2, s = bs & 3;
  const int dil = g == 0 ? 1 : (g == 1 ? 4 : 16);
  const int W = g == 0 ? 128 : (g == 1 ? 512 : 2048);
  const float* cache = g == 0 ? p.cache0 : (g == 1 ? p.cache1 : p.cache2);
  const int row = T + b * 4 + s;
  const float4 q4 = us4_to_f4(*(const ushort4*)(p.QKVG + qs_off(g, row) + h * 64 + l16 * 4));
  const int jstart = g == 0 ? s + 1 : 1;
  for (int j = 0; j < jstart; ++j) {
    const float4 k4 = us4_to_f4(*(const ushort4*)(p.QKVG + qs_off(3 + g, row - dil * j) + h * 64 + l16 * 4));
    const float sc = row16_sum(k4.x * q4.x + k4.y * q4.y + k4.z * q4.z + k4.w * q4.w);
    if (lane == 0) sp[j] = sc;
  }
  const float* cbase = cache + (long)b * W * 1024 + h * 64 + l16 * 4;
#pragma unroll 11
  for (int jj = 0; jj < 33; ++jj) {
    const int j = jstart + jj * 4 + kq, jc = min(j, 128), idx = W + s - dil * jc;
    const float4 k4 = *(const float4*)(cbase + (long)idx * 1024);
    const float sc = row16_sum(k4.x * q4.x + k4.y * q4.y + k4.z * q4.z + k4.w * q4.w);
    if (l16 == 0 && j <= 128) sp[j] = sc;
  }
  __builtin_amdgcn_s_waitcnt(0);
  __builtin_amdgcn_wave_barrier();
  const float a0 = sp[lane], a1 = sp[lane + 64], a2 = lane == 0 ? sp[128] : -1e30f;
  const float mx = wave_max(fmaxf(fmaxf(a0, a1), a2));
  const float e0 = __expf(a0 - mx), e1 = __expf(a1 - mx), e2 = lane == 0 ? __expf(a2 - mx) : 0.f;
  const float sm = wave_sum(e0 + e1 + e2);
  __builtin_amdgcn_wave_barrier();
  sp[lane] = e0; sp[lane + 64] = e1;
  if (lane == 0) sp[128] = e2;
  __builtin_amdgcn_s_waitcnt(0);
  __builtin_amdgcn_wave_barrier();
  float4 acc = make_float4(0.f, 0.f, 0.f, 0.f);
  for (int j = 0; j < jstart; ++j) {
    const float4 v4 = us4_to_f4(*(const ushort4*)(p.QKVG + qs_off(6 + g, row - dil * j) + h * 64 + l16 * 4));
    const float pj = kq == 0 ? sp[j] : 0.f;
    acc.x += pj * v4.x; acc.y += pj * v4.y; acc.z += pj * v4.z; acc.w += pj * v4.w;
  }
#pragma unroll 11
  for (int jj = 0; jj < 33; ++jj) {
    const int j = jstart + jj * 4 + kq, jc = min(j, 128), idx = W + s - dil * jc;
    const float4 v4 = *(const float4*)(cbase + (long)idx * 1024 + 512);
    const float pj = j <= 128 ? sp[jc] : 0.f;
    acc.x += pj * v4.x; acc.y += pj * v4.y; acc.z += pj * v4.z; acc.w += pj * v4.w;
  }
  acc.x += __shfl_xor(acc.x, 16); acc.y += __shfl_xor(acc.y, 16); acc.z += __shfl_xor(acc.z, 16); acc.w += __shfl_xor(acc.w, 16);
  acc.x += __shfl_xor(acc.x, 32); acc.y += __shfl_xor(acc.y, 32); acc.z += __shfl_xor(acc.z, 32); acc.w += __shfl_xor(acc.w, 32);
  const float inv = 1.f / sm;
  if (kq == 0)
    *(float4*)(p.AO + ((long)g * MT + row) * 512 + h * 64 + l16 * 4) = make_float4(acc.x * inv, acc.y * inv, acc.z * inv, acc.w * inv);
  if (lane == 0) p.LSE[((long)g * MT + row) * 8 + h] = mx + __logf(sm);
  __builtin_amdgcn_wave_barrier();
}

__device__ void phaseI(const Params& p, int bid, int nb, char* smem) {
  attn_prompt_phase(p, bid, nb, smem);
  __syncthreads();
  float* sp = (float*)smem + (threadIdx.x >> 6) * 160;
  for (int it = bid * 4 + (threadIdx.x >> 6); it < 3072; it += nb * 4) attn_sample_item(p, it, sp);
}

DEVI float4 bf4_to_f4(uint2 v) {
  return make_float4(__uint_as_float(v.x << 16), __uint_as_float(v.x & 0xffff0000u), __uint_as_float(v.y << 16),
                     __uint_as_float(v.y & 0xffff0000u));
}
__device__ void copy_kv_out(const Params& p, int g, int W, float* kvp, float* kvs, int bid, int nb) {
  const u16* Q = p.QKVG;
  const int np = W * 256;
  const int ns = 32 * 4 * 256;
  for (int i = bid * 256 + threadIdx.x; i < np + ns; i += nb * 256) {
    if (i < np) {
      int r = i >> 8, rem = i & 255, kv = rem >> 7, c4 = rem & 127;
      ((float4*)kvp)[i] = bf4_to_f4(*(const uint2*)(Q + qs_off(3 + kv * 3 + g, qs_perm(T - W + r, g)) + c4 * 4));
    } else {
      int q = i - np, bs = q >> 8, rem = q & 255, kv = rem >> 7, c4 = rem & 127, b = bs >> 2, s = bs & 3;
      ((float4*)kvs)[((long)(b * W + W - 4 + s) * 2 + kv) * 128 + c4] =
          bf4_to_f4(*(const uint2*)(Q + qs_off(3 + kv * 3 + g, T + bs) + c4 * 4));
    }
  }
}

__device__ void phaseI2(const Params& p, int bid, int nb) {
  const int tid = threadIdx.x;
  for (int i = bid * 256 + tid; i < MT * 128; i += nb * 256) {
    int row = i >> 7, c4 = i & 127, h = c4 >> 4;
    float l0 = p.LSE[((long)row) * 8 + h], l1 = p.LSE[((long)MT + row) * 8 + h], l2 = p.LSE[((long)2 * MT + row) * 8 + h];
    float mx = fmaxf(l0, fmaxf(l1, l2));
    float e0 = __expf(l0 - mx), e1 = __expf(l1 - mx), e2 = __expf(l2 - mx);
    float inv = 1.f / (e0 + e1 + e2);
    e0 *= inv; e1 *= inv; e2 *= inv;
    float4 a0 = ((const float4*)p.AO)[(long)row * 128 + c4];
    float4 a1 = ((const float4*)p.AO)[((long)MT + row) * 128 + c4];
    float4 a2 = ((const float4*)p.AO)[((long)2 * MT + row) * 128 + c4];
    float4 gt = bf4_to_f4(*(const uint2*)(p.QKVG + qs_off(9, row) + c4 * 4));
    ushort4 ob;
    ob.x = f2bf((e0 * a0.x + e1 * a1.x + e2 * a2.x) * siluf_(gt.x));
    ob.y = f2bf((e0 * a0.y + e1 * a1.y + e2 * a2.y) * siluf_(gt.y));
    ob.z = f2bf((e0 * a0.z + e1 * a1.z + e2 * a2.z) * siluf_(gt.z));
    ob.w = f2bf((e0 * a0.w + e1 * a1.w + e2 * a2.w) * siluf_(gt.w));
    ((ushort4*)p.O2)[(long)row * 128 + c4] = ob;
  }
  copy_kv_out(p, 0, 128, p.kvp0, p.kvs0, bid, nb);
  copy_kv_out(p, 1, 512, p.kvp1, p.kvs1, bid, nb);
  copy_kv_out(p, 2, 2048, p.kvp2, p.kvs2, bid, nb);
}

#define XB_TMO      128
#define XB_XCNT(j)  (256  + 64 * (j))
#define XB_XSUB(j)  (1280 + 64 * (j))
#define XB_XGEN(j)  (2304 + 64 * (j))
#define XB_TOP      3328
#define XB_TOPGEN   3392
#define XCD_BAR_WORDS 3456
#define XB_SPIN_CAP (1u << 18)
#define LAS __attribute__((address_space(3)))

__device__ __forceinline__ unsigned xb_ld(unsigned* p)              { return __hip_atomic_load(p, __ATOMIC_RELAXED, __HIP_MEMORY_SCOPE_AGENT); }
__device__ __forceinline__ unsigned xb_add(unsigned* p, unsigned v) { return __hip_atomic_fetch_add(p, v, __ATOMIC_RELAXED, __HIP_MEMORY_SCOPE_AGENT); }
__device__ __forceinline__ unsigned xb_xcc_id() { return (unsigned)__builtin_amdgcn_s_getreg((3 << 11) | 20) & 0xFu; }
#define XB_SPIN(cond, bar) do { unsigned _sp = 0; while (cond) { __builtin_amdgcn_s_sleep(1); \
    if ((++_sp & 255u) == 0u) { if (xb_ld(&(bar)[XB_TMO])) break; if (_sp > XB_SPIN_CAP) { atomicAdd(&(bar)[XB_TMO], 1u); break; } } } } while (0)

struct XcdBarrier {
    unsigned* bar; unsigned x;
    volatile LAS unsigned* st;
};

__device__ __forceinline__ XcdBarrier xcd_barrier_post(unsigned* bar, volatile LAS unsigned* st) {
    XcdBarrier b; b.bar = bar; b.x = xb_xcc_id(); b.st = st;
    if (threadIdx.x == 0) (void)xb_add(&bar[XB_XCNT(b.x)], 1u);
    return b;
}
__device__ __forceinline__ void xcd_barrier_complete(unsigned* bar, unsigned x, unsigned& nloc, unsigned& nx) {
    const unsigned G = gridDim.x * gridDim.y * gridDim.z;
    unsigned sum, cnt, mine, sp = 0u;
    for (;;) {
        sum = 0u; cnt = 0u; mine = 0u;
#pragma unroll
        for (unsigned j = 0; j < 16; ++j) { const unsigned c = xb_ld(&bar[XB_XCNT(j)]); sum += c; cnt += (c > 0u) ? 1u : 0u; mine = (j == x) ? c : mine; }
        if (sum == G) break;
        __builtin_amdgcn_s_sleep(1);
        if ((++sp & 255u) == 0u) { if (xb_ld(&bar[XB_TMO])) break; if (sp > XB_SPIN_CAP) { atomicAdd(&bar[XB_TMO], 1u); break; } }
    }
    nloc = mine > 0u ? mine : 1u; nx = cnt > 0u ? cnt : 1u;
}

__device__ __forceinline__ void xcd_barrier(const XcdBarrier& b) {
    asm volatile("s_waitcnt vmcnt(0)" ::: "memory");
    __syncthreads();
    if (threadIdx.x == 0) {
        unsigned* bar = b.bar;
        __builtin_amdgcn_s_waitcnt(0);
        unsigned nloc = b.st[0], nx = b.st[1];
        if (nloc == 0u) { xcd_barrier_complete(bar, b.x, nloc, nx); b.st[0] = nloc; b.st[1] = nx; }
        const unsigned old = xb_add(&bar[XB_XSUB(b.x)], 1u);
        const unsigned gen = old / nloc;
        if (old + 1u == (gen + 1u) * nloc) {
            __builtin_amdgcn_fence(__ATOMIC_RELEASE, "agent");
            asm volatile("s_waitcnt vmcnt(0)" ::: "memory");
            const unsigned og = xb_add(&bar[XB_TOP], 1u);
            const unsigned tg = og / nx;
            if (og + 1u == (tg + 1u) * nx) xb_add(&bar[XB_TOPGEN], 1u);
            else XB_SPIN(xb_ld(&bar[XB_TOPGEN]) == tg, bar);
            __builtin_amdgcn_fence(__ATOMIC_ACQUIRE, "agent");
            xb_add(&bar[XB_XGEN(b.x)], 1u);
            asm volatile("s_waitcnt vmcnt(0)" ::: "memory");
        } else {
            XB_SPIN(xb_ld(&bar[XB_XGEN(b.x)]) == gen, bar);
            __builtin_amdgcn_fence(__ATOMIC_ACQUIRE, "agent");
            asm volatile("s_waitcnt vmcnt(0)" ::: "memory");
        }
    }
    __syncthreads();
}


template <int PH> DEVI void run_phase(const Params& p, int bid, int nb, char* smem) {
  if (PH == 0) phaseA(p, bid, nb, smem);
  if (PH == 1) gemm_big<0>(p.Xb, p.WinE, 1024, 65, 29, p.P, ECP, bid, nb, smem);
  if (PH == 2) phaseC(p, bid, nb, smem);
  if (PH == 3) phaseD1(p, bid, nb, smem);
  if (PH == 4) phaseD2(p, bid, nb, smem);
  if (PH == 5) { phaseD3(p, bid, nb, smem); conv_state_out(p, bid, nb); }
  if (PH == 6) gemm_phase<0>(p.Y, p.WoutE, 1024, 129, 8, p.Z, 1024, nullptr, nullptr, bid, nb, smem);
  if (PH == 7) ln_phase(p.Z, p.x_prompt, p.x_sample, p.ln_g, p.ln_b, p.X1, p.X1 + (long)T * 1024, p.X1b, bid, nb);
  if (PH == 8) gemm_big<2>(p.X1b, p.WinO, 1024, 65, 40, (float*)p.QKVG, OC, bid, nb, smem);
  if (PH == 9) phaseI(p, bid, nb, smem);
  if (PH == 10) phaseI2(p, bid, nb);
  if (PH == 11) gemm_phase<0>(p.O2, p.WoutO, 512, 129, 8, p.Z, 1024, nullptr, nullptr, bid, nb, smem);
  if (PH == 12) ln_phase(p.Z, p.X1, p.X1 + (long)T * 1024, p.ln_g + 1024, p.ln_b + 1024, p.y_prompt, p.y_sample, nullptr, bid, nb);
}
constexpr int NPH = 13;
template <int PH> DEVI void run_all(const Params& p, int bid, int nb, char* smem, const XcdBarrier& xb) {
  run_phase<PH>(p, bid, nb, smem);
  if constexpr (((REPMASK) >> PH) & 1) { xcd_barrier(xb); run_phase<PH>(p, bid, nb, smem); }
  if constexpr (PH + 1 < NPH) { xcd_barrier(xb); run_all<PH + 1>(p, bid, nb, smem, xb); }
}

#if MEGA
__global__ void __launch_bounds__(256, 2) mega_kernel(Params p) {
  __shared__ __attribute__((aligned(16))) char smem[SMEM_BYTES];
  __shared__ uint4 xb_words;
  const int bid = blockIdx.x, nb = gridDim.x;
  if (threadIdx.x == 0) xb_words = make_uint4(0u, 0u, 0u, 0u);
  __syncthreads();
  XcdBarrier xb = xcd_barrier_post(p.bar, (volatile LAS unsigned*)&xb_words);
  if (p.bar == nullptr) cg::this_grid().sync();
#ifdef XSYNC
  for (int i = 0; i < XSYNC; ++i) xcd_barrier(xb);
#endif
  run_all<0>(p, bid, nb, smem, xb);
}
#else
template <int PH> __global__ void __launch_bounds__(256, 2) phase_kernel(Params p) {
  __shared__ __attribute__((aligned(16))) char smem[SMEM_BYTES];
  run_phase<PH>(p, blockIdx.x, gridDim.x, smem);
}
#endif

extern "C" void kernel_launch(void* const* d_in, const int* in_sizes, int n_in, void* d_out, int out_size,
                              void* d_ws, size_t ws_size, hipStream_t stream) {
  Params p{};
  const float** ins = (const float**)&p.x_prompt;
  for (int i = 0; i < 28; ++i) ins[i] = (const float*)d_in[i];
  float* o = (float*)d_out;
  p.y_prompt = o; o += 16777216;
  p.y_sample = o; o += 131072;
  p.conv_p = o; o += 15360;
  p.conv_s = o; o += 491520;
  p.shift_p = o; o += 1024;
  p.shift_s = o; o += 32768;
  p.wkv_p = o; o += 32768;
  p.wkv_s = o; o += 1048576;
  p.kvp0 = o; o += 131072;
  p.kvs0 = o; o += 4194304;
  p.kvp1 = o; o += 524288;
  p.kvs1 = o; o += 16777216;
  p.kvp2 = o; o += 2097152;
  p.kvs2 = o; o += 67108864;
  char* w = (char*)d_ws;
  size_t off = 0;
  auto take = [&](size_t bytes) { char* r = w + off; off += (bytes + 255) & ~(size_t)255; return r; };
  p.Xb = (u16*)take((size_t)MP * 1024 * 2);
  p.WinE = (u16*)take((size_t)ECP * 1024 * 2);
  p.WoutE = (u16*)take((size_t)1024 * 1024 * 2);
  p.WinO = (u16*)take((size_t)OC * 1024 * 2);
  p.WoutO = (u16*)take((size_t)1024 * 512 * 2);
  p.Y = (u16*)take((size_t)MP * 1024 * 2);
  p.X1b = (u16*)take((size_t)MP * 1024 * 2);
  p.O2 = (u16*)take((size_t)MP * 512 * 2);
  p.Z = (float*)take((size_t)MP * 1024 * 4);
  p.X1 = (float*)take((size_t)MP * 1024 * 4);
  size_t offB = off;
  p.P = (float*)take((size_t)MP * ECP * 4);
  p.scan = (float*)take((size_t)6 * SCAN_STRIDE * 4);
  p.U = (float*)take((size_t)(SCAN_STRIDE + 30 * 512) * 4) + 30 * 512;
  p.Oraw = (float*)take((size_t)SCAN_STRIDE * 4);
  p.Gbuf = (float*)take((size_t)8 * NCH * 4096 * 4);
  p.Hbuf = (float*)take((size_t)8 * NCH * 4096 * 4);
  p.Sst = (float*)take((size_t)8 * NCH * 4096 * 4);
  off = offB;
  p.QKVG = (u16*)take((size_t)MP * OC * 2);
  p.AO = (float*)take((size_t)3 * SCAN_STRIDE * 4);
  p.LSE = (float*)take((size_t)3 * MT * 8 * 4);
  off = (size_t)900 << 20;
  p.bar = (unsigned*)take((size_t)XCD_BAR_WORDS * 4);
#if MEGA
  static int grid_blocks = 0;
  if (!grid_blocks) {
    int dev = 0, cus = 0, per_cu = 0;
    hipGetDevice(&dev);
    hipDeviceGetAttribute(&cus, hipDeviceAttributeMultiprocessorCount, dev);
    hipOccupancyMaxActiveBlocksPerMultiprocessor(&per_cu, mega_kernel, 256, 0);
    if (per_cu > 2) per_cu = 2;
    grid_blocks = cus * per_cu;
  }
  hipMemsetAsync(p.bar, 0, (size_t)XCD_BAR_WORDS * 4, stream);
  void* args[] = {&p};
  hipError_t e = hipLaunchCooperativeKernel((void*)mega_kernel, dim3(grid_blocks), dim3(256), args, 0, stream);
  if (e != hipSuccess) fprintf(stderr, "cooperative launch failed: %s (grid %d)\n", hipGetErrorString(e), grid_blocks);
#else
  const int G = 1024;
  phase_kernel<0><<<G, 256, 0, stream>>>(p);
  phase_kernel<1><<<G, 256, 0, stream>>>(p);
  phase_kernel<2><<<G, 256, 0, stream>>>(p);
  phase_kernel<3><<<G, 256, 0, stream>>>(p);
  phase_kernel<4><<<G, 256, 0, stream>>>(p);
  phase_kernel<5><<<G, 256, 0, stream>>>(p);
  phase_kernel<6><<<G, 256, 0, stream>>>(p);
  phase_kernel<7><<<G, 256, 0, stream>>>(p);
  phase_kernel<8><<<G, 256, 0, stream>>>(p);
  phase_kernel<9><<<G, 256, 0, stream>>>(p);
  phase_kernel<10><<<G, 256, 0, stream>>>(p);
  phase_kernel<11><<<G, 256, 0, stream>>>(p);
  phase_kernel<12><<<G, 256, 0, stream>>>(p);
#endif
}
```

```cpp
#include <hip/hip_runtime.h>
#include <hip/hip_bf16.h>
#include <hip/hip_cooperative_groups.h>
#include <cstdio>
namespace cg = cooperative_groups;

#ifndef MEGA
#define MEGA 1
#endif
#ifndef REPMASK
#define REPMASK 0
#endif

typedef __attribute__((ext_vector_type(8))) short bf16x8;
typedef __attribute__((ext_vector_type(4))) float f32x4;
typedef unsigned short u16;
#define DEVI __device__ __forceinline__

constexpr int T = 16384;
constexpr int NS = 128;
constexpr int MT = T + NS;
constexpr int MX = MT + 32;
constexpr int MP = 16640;
constexpr int EC = 3648, ECP = 3712, OC = 5120;
constexpr float ALPHA = 1.41421356237f;
constexpr int SCAN_STRIDE = MT * 512;
constexpr int SMEM_BYTES = 61440;

struct Params {
  const float *x_prompt, *x_sample, *state_conv, *state_shift, *state_wkv, *cache0, *cache1, *cache2;
  const float *w_in_even, *conv_w, *conv_b, *cln_g, *cln_b, *mu, *w0, *w2, *a0, *a2, *k_k, *k_a, *r_k,
      *lnx_g, *lnx_b, *w_out_even, *w_in_odd, *w_out_odd, *ln_g, *ln_b;
  float *y_prompt, *y_sample, *conv_p, *conv_s, *shift_p, *shift_s, *wkv_p, *wkv_s, *kvp0, *kvs0, *kvp1, *kvs1,
      *kvp2, *kvs2;
  u16 *Xb, *WinE, *WoutE, *WinO, *WoutO, *Y, *X1b, *O2;
  float *Z, *X1, *P, *scan, *U, *Oraw, *AO, *LSE, *Gbuf, *Hbuf, *Sst;
  u16* QKVG;
  unsigned* bar;
};

DEVI u16 f2bf(float f) {
  unsigned u = __float_as_uint(f);
  u += 0x7fffu + ((u >> 16) & 1u);
  return (u16)(u >> 16);
}
template <int CTRL> DEVI float dppf(float x) {
  return __builtin_bit_cast(float, __builtin_amdgcn_mov_dpp(__builtin_bit_cast(int, x), CTRL, 0xf, 0xf, true));
}
DEVI float row16_sum(float x) {
  x += dppf<0x128>(x);
  x += dppf<0x124>(x);
  x += dppf<0x4E>(x);
  x += dppf<0xB1>(x);
  return x;
}
DEVI float row16_max(float x) {
  x = fmaxf(x, dppf<0x128>(x));
  x = fmaxf(x, dppf<0x124>(x));
  x = fmaxf(x, dppf<0x4E>(x));
  x = fmaxf(x, dppf<0xB1>(x));
  return x;
}
DEVI float wave_sum(float v) {
  v = row16_sum(v);
  v += __shfl_xor(v, 16);
  v += __shfl_xor(v, 32);
  return v;
}
DEVI float wave_max(float v) {
  v = row16_max(v);
  v = fmaxf(v, __shfl_xor(v, 16));
  v = fmaxf(v, __shfl_xor(v, 32));
  return v;
}
DEVI float frcp(float x) { return __builtin_amdgcn_rcpf(x); }
DEVI float sigmoidf_(float x) { return frcp(1.f + __expf(-x)); }
DEVI float siluf_(float x) { return x * frcp(1.f + __expf(-x)); }
DEVI int prev_row(int row) {
  if (row < T) return row - 1;
  int q = row - T;
  if (q & 3) return row - 1;
  return MT + (q >> 2);
}

__device__ void transpose_tile(const float* __restrict__ W, u16* __restrict__ Wt, int K, int N, int tk, int tn,
                               float* lds) {
  const int tid = threadIdx.x;
  const int k0 = tk * 64, n0 = tn * 64;
  __syncthreads();
  for (int e = tid; e < 4096; e += 256) {
    int kk = e >> 6, nn = e & 63;
    int n = n0 + nn;
    lds[kk * 65 + nn] = (n < N) ? W[(long)(k0 + kk) * N + n] : 0.f;
  }
  __syncthreads();
  for (int e = tid; e < 4096; e += 256) {
    int nn = e >> 6, kk = e & 63;
    Wt[(long)(n0 + nn) * K + k0 + kk] = f2bf(lds[kk * 65 + nn]);
  }
}

template <int W>
__device__ void copy_cache(const float* __restrict__ src, float* __restrict__ dst, int bid, int nb) {
  constexpr int per_b = (W - 4) * 256;
  constexpr int total = 32 * per_b;
  const f32x4* s4 = (const f32x4*)src;
  f32x4* d4 = (f32x4*)dst;
  const int stride = nb * 256;
  for (int i = bid * 256 + threadIdx.x; i < total; i += 4 * stride) {
    f32x4 v[4];
    int o[4];
#pragma unroll
    for (int k = 0; k < 4; ++k) {
      const int idx = i + k * stride;
      const int ii = min(idx, total - 1);
      const int b = ii / per_b, rem = ii - b * per_b;
      o[k] = idx < total ? b * (W * 256) + rem : -1;
      v[k] = __builtin_nontemporal_load(&s4[b * (W * 256) + rem + 1024]);
    }
#pragma unroll
    for (int k = 0; k < 4; ++k)
      if (o[k] >= 0) __builtin_nontemporal_store(v[k], &d4[o[k]]);
  }
}

__device__ void phaseA(const Params& p, int bid, int nb, char* smem) {
  const int tid = threadIdx.x;
  {
    const long total = (long)MP * 256;
#pragma unroll 4
    for (long i = (long)bid * 256 + tid; i < total; i += (long)nb * 256) {
      int row = (int)(i >> 8), c4 = (int)(i & 255);
      float4 v = make_float4(0.f, 0.f, 0.f, 0.f);
      if (row < T) v = ((const float4*)p.x_prompt)[(long)row * 256 + c4];
      else if (row < MT) v = ((const float4*)p.x_sample)[(long)(row - T) * 256 + c4];
      else if (row < MX) v = ((const float4*)p.state_shift)[(long)(row - MT) * 256 + c4];
      ushort4 o;
      o.x = f2bf(v.x); o.y = f2bf(v.y); o.z = f2bf(v.z); o.w = f2bf(v.w);
      ((ushort4*)p.Xb)[i] = o;
    }
  }
  {
    const int n0 = 16 * 58, n1 = n0 + 16 * 16, n2 = n1 + 16 * 80, n3 = n2 + 8 * 16;
    for (int t = bid; t < n3; t += nb) {
      if (t < n0) transpose_tile(p.w_in_even, p.WinE, 1024, EC, t % 16, t / 16, (float*)smem);
      else if (t < n1) transpose_tile(p.w_out_even, p.WoutE, 1024, 1024, (t - n0) % 16, (t - n0) / 16, (float*)smem);
      else if (t < n2) transpose_tile(p.w_in_odd, p.WinO, 1024, OC, (t - n1) % 16, (t - n1) / 16, (float*)smem);
      else transpose_tile(p.w_out_odd, p.WoutO, 512, 1024, (t - n2) % 8, (t - n2) / 8, (float*)smem);
    }
  }
  for (int i = bid * 256 + tid; i < 30 * 512; i += nb * 256) p.U[i - 30 * 512] = 0.f;
  for (int i = bid * 256 + tid; i < 1024 + 32 * 1024; i += nb * 256) {
    if (i < 1024) p.shift_p[i] = p.x_prompt[(long)(T - 1) * 1024 + i];
    else {
      int q = i - 1024, b = q >> 10, c = q & 1023;
      p.shift_s[q] = p.x_sample[(long)(b * 4 + 3) * 1024 + c];
    }
  }
}

DEVI int qs_perm(int t, int g) {
  const int lg = g * 2;
  return t < T ? (t & ((1 << lg) - 1)) * (T >> lg) + (t >> lg) : t;
}
DEVI long qs_off(int sec, int row) { return ((long)sec * MP + row) * 512; }
template <int EPI>
__device__ void gemm_phase(const u16* __restrict__ A, const u16* __restrict__ Bt, int K, int nM, int nN,
                           float* __restrict__ C, int ldc, const float* __restrict__ res0,
                           const float* __restrict__ res1, int bid, int nb, char* smem) {
  u16* sA = (u16*)smem;
  u16* sB = sA + 2 * 5120;
  const int tid = threadIdx.x, lane = tid & 63, w = tid >> 6, wm = w >> 1, wn = w & 1;
  const int lr = lane & 15, lq = lane >> 4;
  const int ntiles = nM * nN, nk = K / 32;
  const int r0 = tid >> 2, kc = tid & 3;
  const int so0 = r0 * 40 + kc * 8, so1 = so0 + 64 * 40;
  for (int tile = bid; tile < ntiles; tile += nb) {
    int nig = 8 * nN, gid = tile / nig, fm = gid * 8, gsz = min(nM - fm, 8);
    int tm = fm + ((tile % nig) % gsz), tn = (tile % nig) / gsz;
    const u16* a0p = A + (long)(tm * 128 + r0) * K + kc * 8;
    const u16* a1p = a0p + 64L * K;
    const u16* b0p = Bt + (long)(tn * 128 + r0) * K + kc * 8;
    const u16* b1p = b0p + 64L * K;
    uint4 ea0 = *(const uint4*)a0p, ea1 = *(const uint4*)a1p, eb0 = *(const uint4*)b0p, eb1 = *(const uint4*)b1p;
    uint4 oa0 = *(const uint4*)(a0p + 32), oa1 = *(const uint4*)(a1p + 32), ob0 = *(const uint4*)(b0p + 32),
          ob1 = *(const uint4*)(b1p + 32);
    f32x4 acc[4][4];
#pragma unroll
    for (int mi = 0; mi < 4; ++mi)
#pragma unroll
      for (int ni = 0; ni < 4; ++ni) acc[mi][ni] = (f32x4){0.f, 0.f, 0.f, 0.f};
    __syncthreads();
    *(uint4*)&sA[so0] = ea0; *(uint4*)&sA[so1] = ea1; *(uint4*)&sB[so0] = eb0; *(uint4*)&sB[so1] = eb1;
    __syncthreads();
    auto compute = [&](int buf) {
      const u16* cA = sA + buf * 5120;
      const u16* cB = sB + buf * 5120;
      bf16x8 af[4], bfr[4];
#pragma unroll
      for (int mi = 0; mi < 4; ++mi) af[mi] = *(const bf16x8*)&cA[(wm * 64 + mi * 16 + lr) * 40 + lq * 8];
#pragma unroll
      for (int ni = 0; ni < 4; ++ni) bfr[ni] = *(const bf16x8*)&cB[(wn * 64 + ni * 16 + lr) * 40 + lq * 8];
#pragma unroll
      for (int mi = 0; mi < 4; ++mi)
#pragma unroll
        for (int ni = 0; ni < 4; ++ni)
          acc[mi][ni] = __builtin_amdgcn_mfma_f32_16x16x32_bf16(af[mi], bfr[ni], acc[mi][ni], 0, 0, 0);
    };
    for (int kt = 0; kt < nk; kt += 2) {
      {
        const int kn = min(kt + 2, nk - 1) * 32;
        ea0 = *(const uint4*)(a0p + kn); ea1 = *(const uint4*)(a1p + kn);
        eb0 = *(const uint4*)(b0p + kn); eb1 = *(const uint4*)(b1p + kn);
      }
      __builtin_amdgcn_sched_barrier(0);
      compute(0);
      __builtin_amdgcn_sched_barrier(0);
      *(uint4*)&sA[5120 + so0] = oa0; *(uint4*)&sA[5120 + so1] = oa1;
      *(uint4*)&sB[5120 + so0] = ob0; *(uint4*)&sB[5120 + so1] = ob1;
      __syncthreads();
      {
        const int kn = min(kt + 3, nk - 1) * 32;
        oa0 = *(const uint4*)(a0p + kn); oa1 = *(const uint4*)(a1p + kn);
        ob0 = *(const uint4*)(b0p + kn); ob1 = *(const uint4*)(b1p + kn);
      }
      __builtin_amdgcn_sched_barrier(0);
      compute(1);
      __builtin_amdgcn_sched_barrier(0);
      *(uint4*)&sA[so0] = ea0; *(uint4*)&sA[so1] = ea1; *(uint4*)&sB[so0] = eb0; *(uint4*)&sB[so1] = eb1;
      __syncthreads();
    }
#pragma unroll
    for (int mi = 0; mi < 4; ++mi) {
#pragma unroll
      for (int j = 0; j < 4; ++j) {
        const int row = tm * 128 + wm * 64 + mi * 16 + lq * 4 + j;
        const int col = tn * 128 + wn * 64 + lr;
        float* cp = C + (long)row * ldc + col;
        if (EPI == 2) {
          u16* cb = (u16*)C + (long)row * ldc + col;
          const float sc = (tn * 128 < 1536) ? 0.125f : 1.f;
#pragma unroll
          for (int ni = 0; ni < 4; ++ni) cb[ni * 16] = f2bf(acc[mi][ni][j] * sc);
        } else if (EPI == 1) {
          const float* rp = (row < T ? res0 + (long)row * 1024 : res1 + (long)(row - T) * 1024) + col;
#pragma unroll
          for (int ni = 0; ni < 4; ++ni) cp[ni * 16] = acc[mi][ni][j] + ALPHA * rp[ni * 16];
        } else {
#pragma unroll
          for (int ni = 0; ni < 4; ++ni) cp[ni * 16] = acc[mi][ni][j];
        }
      }
      asm volatile("" ::: "memory");
    }
  }
}

template <int EPI>
__device__ void gemm_big(const u16* __restrict__ A, const u16* __restrict__ Bt, int K, int nM, int nN,
                         float* __restrict__ C, int ldc, int bid, int nb, char* smem) {
  u16* sA = (u16*)smem;
  u16* sB = sA + 2 * 10240;
  const int tid = threadIdx.x, lane = tid & 63, w = tid >> 6, wm = w >> 1, wn = w & 1;
  const int lr = lane & 15, lq = lane >> 4;
  const int ntiles = nM * nN, nk = K / 32;
  const int r0 = tid >> 2, kc = tid & 3;
  const int so = r0 * 40 + kc * 8;
  for (int tile = bid; tile < ntiles; tile += nb) {
    int nig = 8 * nN, gid = tile / nig, fm = gid * 8, gsz = min(nM - fm, 8);
    int tm = fm + ((tile % nig) % gsz), tn = (tile % nig) / gsz;
    const u16* ap = A + (long)(tm * 256 + r0) * K + kc * 8;
    const u16* bp = Bt + (long)(tn * 128 + r0) * K + kc * 8;
    uint4 ra0 = *(const uint4*)ap, ra1 = *(const uint4*)(ap + 64L * K), ra2 = *(const uint4*)(ap + 128L * K),
          ra3 = *(const uint4*)(ap + 192L * K);
    uint4 rb0 = *(const uint4*)bp, rb1 = *(const uint4*)(bp + 64L * K);
    f32x4 acc[8][4];
#pragma unroll
    for (int mi = 0; mi < 8; ++mi)
#pragma unroll
      for (int ni = 0; ni < 4; ++ni) acc[mi][ni] = (f32x4){0.f, 0.f, 0.f, 0.f};
    __syncthreads();
    *(uint4*)&sA[so] = ra0; *(uint4*)&sA[so + 2560] = ra1; *(uint4*)&sA[so + 5120] = ra2; *(uint4*)&sA[so + 7680] = ra3;
    *(uint4*)&sB[so] = rb0; *(uint4*)&sB[so + 2560] = rb1;
    __syncthreads();
    for (int kt = 0; kt < nk; ++kt) {
      const int buf = kt & 1;
      {
        const int kn = min(kt + 1, nk - 1) * 32;
        ra0 = *(const uint4*)(ap + kn); ra1 = *(const uint4*)(ap + 64L * K + kn);
        ra2 = *(const uint4*)(ap + 128L * K + kn); ra3 = *(const uint4*)(ap + 192L * K + kn);
        rb0 = *(const uint4*)(bp + kn); rb1 = *(const uint4*)(bp + 64L * K + kn);
      }
      __builtin_amdgcn_sched_barrier(0);
      const u16* cA = sA + buf * 10240;
      const u16* cB = sB + buf * 5120;
      bf16x8 bfr[4];
#pragma unroll
      for (int ni = 0; ni < 4; ++ni) bfr[ni] = *(const bf16x8*)&cB[(wn * 64 + ni * 16 + lr) * 40 + lq * 8];
      bf16x8 afr[8];
#pragma unroll
      for (int mi = 0; mi < 8; ++mi) afr[mi] = *(const bf16x8*)&cA[(wm * 128 + mi * 16 + lr) * 40 + lq * 8];
      __builtin_amdgcn_s_setprio(1);
#pragma unroll
      for (int mi = 0; mi < 8; ++mi) {
#pragma unroll
        for (int ni = 0; ni < 4; ++ni)
          acc[mi][ni] = __builtin_amdgcn_mfma_f32_16x16x32_bf16(afr[mi], bfr[ni], acc[mi][ni], 0, 0, 0);
      }
      __builtin_amdgcn_s_setprio(0);
      __builtin_amdgcn_sched_barrier(0);
      {
        u16* nA = sA + (buf ^ 1) * 10240;
        u16* nB = sB + (buf ^ 1) * 5120;
        *(uint4*)&nA[so] = ra0; *(uint4*)&nA[so + 2560] = ra1; *(uint4*)&nA[so + 5120] = ra2; *(uint4*)&nA[so + 7680] = ra3;
        *(uint4*)&nB[so] = rb0; *(uint4*)&nB[so + 2560] = rb1;
      }
      __syncthreads();
    }
#pragma unroll
    for (int mi = 0; mi < 8; ++mi) {
#pragma unroll
      for (int j = 0; j < 4; ++j) {
        const int row = tm * 256 + wm * 128 + mi * 16 + lq * 4 + j;
        const int col = tn * 128 + wn * 64 + lr;
        if (EPI == 2) {
          const int sec = tn >> 2;
          const int orow = sec < 9 ? qs_perm(row, sec % 3) : row;
          u16* cb = (u16*)C + qs_off(sec, orow) + (tn & 3) * 128 + wn * 64 + lr;
          const float sc = (tn * 128 < 1536) ? 0.125f : 1.f;
#pragma unroll
          for (int ni = 0; ni < 4; ++ni) cb[ni * 16] = f2bf(acc[mi][ni][j] * sc);
        } else {
          float* cp = C + (long)row * ldc + col;
#pragma unroll
          for (int ni = 0; ni < 4; ++ni) cp[ni * 16] = acc[mi][ni][j];
        }
      }
      asm volatile("" ::: "memory");
    }
  }
}

__device__ void phaseC(const Params& p, int bid, int nb, char* smem) {
  float* lwd = (float*)smem;
  float* lad = lwd + 256;
  const int tid = threadIdx.x;
  const float* __restrict__ P = p.P;
#pragma unroll 1
  for (int half = 0; half < 2; ++half) {
    const int c = tid + half * 256;
    float w2c[32], a2c[32];
#pragma unroll
    for (int l = 0; l < 32; ++l) { w2c[l] = p.w2[l * 512 + c]; a2c[l] = p.a2[l * 512 + c]; }
    const float w0c = p.w0[c], a0c = p.a0[c];
    const float mur = p.mu[c], muk = p.mu[512 + c], muv = p.mu[1024 + c];
    const float kkc = p.k_k[c], kac = p.k_a[c];
    const float mwa = p.mu[1536 + (tid & 63)];
    for (int it = bid; it < MT / 8; it += nb) {
      const int row0 = it * 8;
      __syncthreads();
#pragma unroll
      for (int e = tid; e < 512; e += 256) {
        int r = e >> 6, cc = e & 63;
        int row = row0 + r, prow = prev_row(row);
        float cur = P[(long)row * ECP + 1536 + cc];
        float prv = prow >= 0 ? P[(long)prow * ECP + 1536 + cc] : 0.f;
        float val = cur + (prv - cur) * mwa;
        if (cc < 32) lwd[r * 32 + cc] = 1.f - 2.f * frcp(1.f + __expf(2.f * val));
        else lad[r * 32 + cc - 32] = val;
      }
      __syncthreads();
      float cum = 1.f;
#pragma unroll 4
      for (int r = 0; r < 8; ++r) {
        const int row = row0 + r, prow = prev_row(row);
        const float* pc = P + (long)row * ECP;
        const float cr = pc[c], ck = pc[512 + c], cv = pc[1024 + c], cval = pc[1600 + c], cglu = pc[2112 + c];
        float pr = 0.f, pk = 0.f, pv = 0.f;
        if (prow >= 0) { const float* pp = P + (long)prow * ECP; pr = pp[c]; pk = pp[512 + c]; pv = pp[1024 + c]; }
        float aw = w0c, aa = a0c;
#pragma unroll
        for (int l4 = 0; l4 < 8; ++l4) {
          const float4 x = *(const float4*)&lwd[r * 32 + l4 * 4];
          const float4 y = *(const float4*)&lad[r * 32 + l4 * 4];
          aw += x.x * w2c[l4 * 4] + x.y * w2c[l4 * 4 + 1] + x.z * w2c[l4 * 4 + 2] + x.w * w2c[l4 * 4 + 3];
          aa += y.x * a2c[l4 * 4] + y.y * a2c[l4 * 4 + 1] + y.z * a2c[l4 * 4 + 2] + y.w * a2c[l4 * 4 + 3];
        }
        float rr = cr + (pr - cr) * mur, kx = ck + (pk - ck) * muk, vv = cv + (pv - cv) * muv;
        float z = -aw;
        float sp = fmaxf(z, 0.f) + __logf(1.f + __expf(-fabsf(z)));
        float decay = __expf(-__expf(-sp - 0.5f));
        float a = sigmoidf_(aa);
        float kkv = kx * kkc;
        float ss = wave_sum(kkv * kkv);
        kkv = kkv * fminf(__builtin_amdgcn_rsqf(ss), 1e12f);
        float kmod = kx * (1.f + (a - 1.f) * kac);
        const float cprev = (r == 0 || (r == 4 && row0 >= T)) ? 1.f : cum;
        cum = cprev * decay;
        const float cinv = frcp(cum);
        float* so = p.scan + (long)row * 3072 + c;
        so[0] = rr * cum;
        so[512] = cum;
        so[1024] = kmod * cinv;
        so[1536] = vv;
        so[2048] = kkv * cprev;
        so[2560] = -(kkv * a) * cinv;
        p.U[(long)row * 512 + c] = cval * sigmoidf_(cglu);
      }
    }
  }
}

typedef float f2 __attribute__((ext_vector_type(2)));
constexpr int CH = 128;
constexpr int NCH = T / CH;
DEVI float row8_sum(float x) {
  x += dppf<0x141>(x);
  x += dppf<0x4E>(x);
  x += dppf<0xB1>(x);
  return x;
}
template <int R, bool P1>
__device__ void scan_chunk(const Params& p, int h, int row0, int nsteps, const float* __restrict__ init,
                           float* __restrict__ fin0, float* __restrict__ fin1, char* smem) {
  constexpr bool OUT = !P1;
  float* buf = (float*)smem;
  const int tid = threadIdx.x, lane = tid & 63, w = tid >> 6, cg = lane & 7, rg = lane >> 3;
  const int rowb = w * 8 * R + rg * R, j0 = cg * 8;
  const bool isG = P1 && (rowb >= 64);
  const int ib = rowb & 63;
  f2 S[R][4];
#pragma unroll
  for (int rr = 0; rr < R; ++rr) {
    if (!P1) {
      float4 t0 = *(const float4*)(init + (ib + rr) * 64 + j0), t1 = *(const float4*)(init + (ib + rr) * 64 + j0 + 4);
      S[rr][0] = (f2){t0.x, t0.y}; S[rr][1] = (f2){t0.z, t0.w};
      S[rr][2] = (f2){t1.x, t1.y}; S[rr][3] = (f2){t1.z, t1.w};
    } else {
      int d = isG ? ib + rr - j0 : -1;
#pragma unroll
      for (int q = 0; q < 4; ++q) S[rr][q] = (f2){d == 2 * q ? 1.f : 0.f, d == 2 * q + 1 ? 1.f : 0.f};
    }
  }
  const int nch = (nsteps + 15) >> 4;
  const float* __restrict__ sc = p.scan;
  float4 pre[6];
  __syncthreads();
#pragma unroll
  for (int q = 0; q < 6; ++q) {
    int e = tid + q * 256, st = e / 96, rem = e - st * 96, a = rem >> 4, f4 = rem & 15;
    pre[q] = make_float4(0.f, 0.f, 0.f, 0.f);
    if (st < nsteps) pre[q] = *(const float4*)(sc + (long)(row0 + st) * 3072 + a * 512 + h * 64 + f4 * 4);
  }
#pragma unroll
  for (int q = 0; q < 6; ++q) *(float4*)(buf + (tid + q * 256) * 4) = pre[q];
  __syncthreads();
  for (int c = 0; c < nch; ++c) {
    const int s0 = c * 16;
    const int n = min(16, nsteps - s0);
    if (c + 1 < nch) {
#pragma unroll
      for (int q = 0; q < 6; ++q) {
        int e = tid + q * 256, st = e / 96, rem = e - st * 96, a = rem >> 4, f4 = rem & 15;
        int gs = s0 + 16 + st;
        pre[q] = make_float4(0.f, 0.f, 0.f, 0.f);
        if (gs < nsteps) pre[q] = *(const float4*)(sc + (long)(row0 + gs) * 3072 + a * 512 + h * 64 + f4 * 4);
      }
    }
    const float* cb = buf + (c & 1) * 6144;
#pragma unroll 2
    for (int s = 0; s < n; ++s) {
      const float* L = cb + s * 384;
      f2 kv[4], kkv[4], nbv[4], rv[4];
      {
        const float4 a = *(const float4*)(L + 128 + j0), b = *(const float4*)(L + 128 + j0 + 4);
        kv[0] = (f2){a.x, a.y}; kv[1] = (f2){a.z, a.w}; kv[2] = (f2){b.x, b.y}; kv[3] = (f2){b.z, b.w};
      }
      {
        const float4 a = *(const float4*)(L + 256 + j0), b = *(const float4*)(L + 256 + j0 + 4);
        kkv[0] = (f2){a.x, a.y}; kkv[1] = (f2){a.z, a.w}; kkv[2] = (f2){b.x, b.y}; kkv[3] = (f2){b.z, b.w};
      }
      {
        const float4 a = *(const float4*)(L + 320 + j0), b = *(const float4*)(L + 320 + j0 + 4);
        nbv[0] = (f2){a.x, a.y}; nbv[1] = (f2){a.z, a.w}; nbv[2] = (f2){b.x, b.y}; nbv[3] = (f2){b.z, b.w};
      }
      if (OUT) {
        const float4 a = *(const float4*)(L + j0), b = *(const float4*)(L + j0 + 4);
        rv[0] = (f2){a.x, a.y}; rv[1] = (f2){a.z, a.w}; rv[2] = (f2){b.x, b.y}; rv[3] = (f2){b.z, b.w};
      }
      float vi[R];
      if (R == 4) {
        const float4 t = *(const float4*)(L + 192 + ib);
        vi[0] = t.x; vi[1] = t.y; vi[2] = t.z; vi[R - 1] = t.w;
      } else {
        const float2 t = *(const float2*)(L + 192 + ib);
        vi[0] = t.x; vi[1] = t.y;
      }
      float o[R], sum[R];
      f2 t[R];
#pragma unroll
      for (int rr = 0; rr < R; ++rr) t[rr] = S[rr][0] * kkv[0];
#pragma unroll
      for (int rr = 0; rr < R; ++rr) t[rr] = __builtin_elementwise_fma(S[rr][1], kkv[1], t[rr]);
#pragma unroll
      for (int rr = 0; rr < R; ++rr) t[rr] = __builtin_elementwise_fma(S[rr][2], kkv[2], t[rr]);
#pragma unroll
      for (int rr = 0; rr < R; ++rr) t[rr] = __builtin_elementwise_fma(S[rr][3], kkv[3], t[rr]);
#pragma unroll
      for (int rr = 0; rr < R; ++rr) sum[rr] = t[rr].x + t[rr].y;
#pragma unroll
      for (int rr = 0; rr < R; ++rr) sum[rr] += dppf<0x141>(sum[rr]);
#pragma unroll
      for (int rr = 0; rr < R; ++rr) sum[rr] += dppf<0x4E>(sum[rr]);
#pragma unroll
      for (int rr = 0; rr < R; ++rr) sum[rr] += dppf<0xB1>(sum[rr]);
      if (isG) {
#pragma unroll
        for (int q = 0; q < 4; ++q)
#pragma unroll
          for (int rr = 0; rr < R; ++rr) S[rr][q] = __builtin_elementwise_fma(nbv[q], (f2){sum[rr], sum[rr]}, S[rr][q]);
      } else {
#pragma unroll
        for (int q = 0; q < 4; ++q)
#pragma unroll
          for (int rr = 0; rr < R; ++rr)
            S[rr][q] = __builtin_elementwise_fma(kv[q], (f2){vi[rr], vi[rr]}, __builtin_elementwise_fma(nbv[q], (f2){sum[rr], sum[rr]}, S[rr][q]));
      }
      if (OUT) {
#pragma unroll
        for (int rr = 0; rr < R; ++rr) t[rr] = S[rr][0] * rv[0];
#pragma unroll
        for (int rr = 0; rr < R; ++rr) t[rr] = __builtin_elementwise_fma(S[rr][1], rv[1], t[rr]);
#pragma unroll
        for (int rr = 0; rr < R; ++rr) t[rr] = __builtin_elementwise_fma(S[rr][2], rv[2], t[rr]);
#pragma unroll
        for (int rr = 0; rr < R; ++rr) t[rr] = __builtin_elementwise_fma(S[rr][3], rv[3], t[rr]);
#pragma unroll
        for (int rr = 0; rr < R; ++rr) o[rr] = t[rr].x + t[rr].y;
#pragma unroll
        for (int rr = 0; rr < R; ++rr) o[rr] += dppf<0x141>(o[rr]);
#pragma unroll
        for (int rr = 0; rr < R; ++rr) o[rr] += dppf<0x4E>(o[rr]);
#pragma unroll
        for (int rr = 0; rr < R; ++rr) o[rr] += dppf<0xB1>(o[rr]);
      }
      if ((s & 7) == 7 || s == n - 1) {
        const float4 a = *(const float4*)(L + 64 + j0), b = *(const float4*)(L + 64 + j0 + 4);
        const f2 c0 = {a.x, a.y}, c1 = {a.z, a.w}, c2 = {b.x, b.y}, c3 = {b.z, b.w};
#pragma unroll
        for (int rr = 0; rr < R; ++rr) { S[rr][0] *= c0; S[rr][1] *= c1; S[rr][2] *= c2; S[rr][3] *= c3; }
      }
      if (OUT && cg == 0) {
        float* op = buf + 12288 + s * 64 + ib;
        if (R == 4) *(float4*)op = make_float4(o[0], o[1], o[2], o[R - 1]);
        else *(float2*)op = make_float2(o[0], o[1]);
      }
    }
    if (OUT) {
      __syncthreads();
      const int tk = tid >> 4, ch = (tid & 15) * 4;
      if (tk < n) {
        const float4 o4 = *(const float4*)(buf + 12288 + tk * 64 + ch);
        const float mean = row16_sum(o4.x + o4.y + o4.z + o4.w) * (1.f / 64.f);
        const float d0 = o4.x - mean, d1 = o4.y - mean, d2 = o4.z - mean, d3 = o4.w - mean;
        const float rstd = rsqrtf(row16_sum(d0 * d0 + d1 * d1 + d2 * d2 + d3 * d3) * (1.f / 64.f) + 64e-5f);
        const float* L = cb + tk * 384;
        const float4 r4 = *(const float4*)(L + ch), k4 = *(const float4*)(L + 128 + ch), v4 = *(const float4*)(L + 192 + ch);
        const float4 rk4 = *(const float4*)(p.r_k + h * 64 + ch);
        const float4 lg = *(const float4*)(p.lnx_g + h * 64 + ch), lb = *(const float4*)(p.lnx_b + h * 64 + ch);
        const float bsum = row16_sum(r4.x * k4.x * rk4.x + r4.y * k4.y * rk4.y + r4.z * k4.z * rk4.z + r4.w * k4.w * rk4.w);
        const long row = row0 + s0 + tk;
        const float4 gt = *(const float4*)(p.P + row * ECP + 3136 + h * 64 + ch);
        ushort4 ob;
        ob.x = f2bf((d0 * rstd * lg.x + lb.x + bsum * v4.x) * siluf_(gt.x));
        ob.y = f2bf((d1 * rstd * lg.y + lb.y + bsum * v4.y) * siluf_(gt.y));
        ob.z = f2bf((d2 * rstd * lg.z + lb.z + bsum * v4.z) * siluf_(gt.z));
        ob.w = f2bf((d3 * rstd * lg.w + lb.w + bsum * v4.w) * siluf_(gt.w));
        *(ushort4*)(p.Y + row * 1024 + 512 + h * 64 + ch) = ob;
      }
    }
    if (c + 1 < nch) {
      float* nbuf = buf + ((c + 1) & 1) * 6144;
#pragma unroll
      for (int q = 0; q < 6; ++q) *(float4*)(nbuf + (tid + q * 256) * 4) = pre[q];
    }
    __syncthreads();
  }
  float* fin = isG ? fin1 : fin0;
  if (fin) {
#pragma unroll
    for (int rr = 0; rr < R; ++rr) {
      *(float4*)(fin + (ib + rr) * 64 + j0) = make_float4(S[rr][0].x, S[rr][0].y, S[rr][1].x, S[rr][1].y);
      *(float4*)(fin + (ib + rr) * 64 + j0 + 4) = make_float4(S[rr][2].x, S[rr][2].y, S[rr][3].x, S[rr][3].y);
    }
  }
}

__device__ void scan_pass2(const Params& p, int item, char* smem) {
  float* sS = (float*)smem;
  float* red = sS + 512;
  const int tid = threadIdx.x, q = tid >> 6, j = tid & 63;
  const int h = item >> 3, i0 = (item & 7) * 8;
  const int oi = tid >> 5, oj = (tid & 31) * 2;
  float s0 = 0.f, s1 = 0.f;
  float g[16], gn[16];
  const float* Gh = p.Gbuf + (long)h * NCH * 4096;
  const float* Hh = p.Hbuf + (long)h * NCH * 4096;
  float* Sh = p.Sst + (long)h * NCH * 4096;
#pragma unroll
  for (int u = 0; u < 16; ++u) g[u] = Gh[(q * 16 + u) * 64 + j];
  float2 hv = *(const float2*)(Hh + (i0 + oi) * 64 + oj), hn = hv;
  __syncthreads();
  for (int c = 0; c < NCH; ++c) {
    *(float2*)(Sh + (long)c * 4096 + (i0 + oi) * 64 + oj) = make_float2(s0, s1);
    sS[oj * 8 + oi] = s0;
    sS[(oj + 1) * 8 + oi] = s1;
    __syncthreads();
    if (c + 1 < NCH) {
#pragma unroll
      for (int u = 0; u < 16; ++u) gn[u] = Gh[(long)(c + 1) * 4096 + (q * 16 + u) * 64 + j];
      hn = *(const float2*)(Hh + (long)(c + 1) * 4096 + (i0 + oi) * 64 + oj);
    }
    float acc[8];
#pragma unroll
    for (int i = 0; i < 8; ++i) acc[i] = 0.f;
#pragma unroll
    for (int u = 0; u < 16; ++u) {
      const int jp = q * 16 + u;
      const float4 sa = *(const float4*)(sS + jp * 8), sb = *(const float4*)(sS + jp * 8 + 4);
      acc[0] += sa.x * g[u]; acc[1] += sa.y * g[u]; acc[2] += sa.z * g[u]; acc[3] += sa.w * g[u];
      acc[4] += sb.x * g[u]; acc[5] += sb.y * g[u]; acc[6] += sb.z * g[u]; acc[7] += sb.w * g[u];
    }
#pragma unroll
    for (int i = 0; i < 8; ++i) red[(q * 8 + i) * 64 + j] = acc[i];
    __syncthreads();
    s0 = hv.x; s1 = hv.y;
    hv = hn;
#pragma unroll
    for (int qq = 0; qq < 4; ++qq) {
      const float2 rv = *(const float2*)(red + (qq * 8 + oi) * 64 + oj);
      s0 += rv.x; s1 += rv.y;
    }
#pragma unroll
    for (int u = 0; u < 16; ++u) g[u] = gn[u];
  }
  *(float2*)(p.wkv_p + h * 4096 + (i0 + oi) * 64 + oj) = make_float2(s0, s1);
}

DEVI void conv1(const Params& p, int row0, int ch, float (&a)[4]) {
  const bool prm = row0 < T;
  const int bb = (row0 - T) >> 2;
  const float* pb = p.U + (long)(row0 - 30) * 512 + ch;
  const float* pa = prm ? pb : p.state_conv + (long)(bb * 30) * 512 + ch;
  float u[34];
#pragma unroll
  for (int e = 0; e < 34; ++e) u[e] = (e < 30 ? pa : pb)[e * 512];
  const float cb0 = p.conv_b[ch];
#pragma unroll
  for (int r = 0; r < 4; ++r) a[r] = cb0;
#pragma unroll
  for (int j = 0; j < 31; ++j) {
    const float w0 = p.conv_w[j * 512 + ch];
#pragma unroll
    for (int r = 0; r < 4; ++r) a[r] += w0 * u[j + r];
  }
}
__device__ void conv_wave_item(const Params& p, int grp, float* cbuf  ) {
  const int lane = threadIdx.x & 63;
  const int row0 = grp * 4;
  float s0 = 0.f, s1 = 0.f, s2 = 0.f, s3 = 0.f;
#pragma unroll 1
  for (int c = 0; c < 8; ++c) {
    float a[4];
    conv1(p, row0, c * 64 + lane, a);
    s0 += a[0]; s1 += a[1]; s2 += a[2]; s3 += a[3];
    cbuf[(c * 4 + 0) * 64 + lane] = a[0]; cbuf[(c * 4 + 1) * 64 + lane] = a[1];
    cbuf[(c * 4 + 2) * 64 + lane] = a[2]; cbuf[(c * 4 + 3) * 64 + lane] = a[3];
  }
  const float m0 = wave_sum(s0) * (1.f / 512.f), m1 = wave_sum(s1) * (1.f / 512.f), m2 = wave_sum(s2) * (1.f / 512.f),
              m3 = wave_sum(s3) * (1.f / 512.f);
  float q0 = 0.f, q1 = 0.f, q2 = 0.f, q3 = 0.f;
#pragma unroll
  for (int c = 0; c < 8; ++c) {
    const float d0 = cbuf[(c * 4 + 0) * 64 + lane] - m0, d1 = cbuf[(c * 4 + 1) * 64 + lane] - m1,
                d2 = cbuf[(c * 4 + 2) * 64 + lane] - m2, d3 = cbuf[(c * 4 + 3) * 64 + lane] - m3;
    q0 += d0 * d0; q1 += d1 * d1; q2 += d2 * d2; q3 += d3 * d3;
  }
  const float r0 = rsqrtf(wave_sum(q0) * (1.f / 512.f) + 1e-5f), r1 = rsqrtf(wave_sum(q1) * (1.f / 512.f) + 1e-5f),
              r2 = rsqrtf(wave_sum(q2) * (1.f / 512.f) + 1e-5f), r3 = rsqrtf(wave_sum(q3) * (1.f / 512.f) + 1e-5f);
#pragma unroll 2
  for (int c = 0; c < 8; ++c) {
    const int ch = c * 64 + lane;
    const float lg = p.cln_g[ch], lb = p.cln_b[ch];
    const float y0 = (cbuf[(c * 4 + 0) * 64 + lane] - m0) * r0 * lg + lb, y1 = (cbuf[(c * 4 + 1) * 64 + lane] - m1) * r1 * lg + lb,
                y2 = (cbuf[(c * 4 + 2) * 64 + lane] - m2) * r2 * lg + lb, y3 = (cbuf[(c * 4 + 3) * 64 + lane] - m3) * r3 * lg + lb;
    const float g0 = p.P[(long)(row0 + 0) * ECP + 2624 + ch], g1 = p.P[(long)(row0 + 1) * ECP + 2624 + ch],
                g2 = p.P[(long)(row0 + 2) * ECP + 2624 + ch], g3 = p.P[(long)(row0 + 3) * ECP + 2624 + ch];
    p.Y[(long)(row0 + 0) * 1024 + ch] = f2bf(siluf_(y0) * siluf_(g0));
    p.Y[(long)(row0 + 1) * 1024 + ch] = f2bf(siluf_(y1) * siluf_(g1));
    p.Y[(long)(row0 + 2) * 1024 + ch] = f2bf(siluf_(y2) * siluf_(g2));
    p.Y[(long)(row0 + 3) * 1024 + ch] = f2bf(siluf_(y3) * siluf_(g3));
  }
}

__device__ void phaseD1(const Params& p, int bid, int nb, char* smem) {
  for (int it = bid; it < 8 * NCH; it += nb) {
    const int h = it / NCH, c = it - h * NCH;
    scan_chunk<4, true>(p, h, c * CH, CH, nullptr, p.Hbuf + (long)it * 4096, p.Gbuf + (long)it * 4096, smem);
  }
  for (int it = bid; it < 256; it += nb) {
    const int b = it >> 3, h = it & 7;
    scan_chunk<2, false>(p, h, T + b * 4, 4, p.state_wkv + (long)it * 4096, p.wkv_s + (long)it * 4096, nullptr, smem);
  }
  __syncthreads();
  for (int g = bid * 4 + (threadIdx.x >> 6); g < MT / 4; g += nb * 4) conv_wave_item(p, g, (float*)smem + (threadIdx.x >> 6) * 2048);
}
__device__ void phaseD2(const Params& p, int bid, int nb, char* smem) {
  if (bid < 64) { scan_pass2(p, bid, smem); return; }
  copy_cache<128>(p.cache0, p.kvs0, bid - 64, nb - 64);
  copy_cache<512>(p.cache1, p.kvs1, bid - 64, nb - 64);
  copy_cache<2048>(p.cache2, p.kvs2, bid - 64, nb - 64);
}
__device__ void phaseD3(const Params& p, int bid, int nb, char* smem) {
  for (int it = bid; it < 8 * NCH; it += nb) {
    const int h = it / NCH, c = it - h * NCH;
    scan_chunk<2, false>(p, h, c * CH, CH, p.Sst + (long)it * 4096, nullptr, nullptr, smem);
  }
}

__device__ void conv_state_out(const Params& p, int bid, int nb) {
  for (int i = bid * 256 + threadIdx.x; i < 15360 + 491520; i += nb * 256) {
    if (i < 15360) p.conv_p[i] = p.U[(long)(T - 30) * 512 + i];
    else {
      int q = i - 15360, b = q / 15360, rem = q - b * 15360, r = rem >> 9, ch = rem & 511;
      p.conv_s[q] = r < 26 ? p.state_conv[(long)(b * 30 + r + 4) * 512 + ch] : p.U[(long)(T + b * 4 + r - 26) * 512 + ch];
    }
  }
}

__device__ void ln_phase(const float* __restrict__ Z, const float* res0, const float* res1,
                         const float* __restrict__ g, const float* __restrict__ bta,
                         float* out0, float* out1, u16* outb, int bid, int nb) {
  const int lane = threadIdx.x & 63, w = threadIdx.x >> 6;
#pragma unroll 2
  for (int row = bid * 4 + w; row < MT; row += nb * 4) {
    const float4* z4 = (const float4*)(Z + (long)row * 1024);
    float4 v[4];
    float s = 0.f;
    const float4* r4 =(const float4*)(row < T ? res0 + (long)row * 1024 : res1 + (long)(row - T) * 1024);
#pragma unroll
    for (int i = 0; i < 4; ++i) {
      float4 z = z4[lane + i * 64], r = r4[lane + i * 64];
      v[i].x = z.x + ALPHA * r.x; v[i].y = z.y + ALPHA * r.y; v[i].z = z.z + ALPHA * r.z; v[i].w = z.w + ALPHA * r.w;
      s += v[i].x + v[i].y + v[i].z + v[i].w;
    }
    float mean = wave_sum(s) * (1.f / 1024.f);
    float q = 0.f;
#pragma unroll
    for (int i = 0; i < 4; ++i) {
      float a = v[i].x - mean, b = v[i].y - mean, c = v[i].z - mean, d = v[i].w - mean;
      q += a * a + b * b + c * c + d * d;
    }
    float rstd = rsqrtf(wave_sum(q) * (1.f / 1024.f) + 1e-5f);
    float* op = row < T ? out0 + (long)row * 1024 : out1 + (long)(row - T) * 1024;
#pragma unroll
    for (int i = 0; i < 4; ++i) {
      float4 gg = ((const float4*)g)[lane + i * 64], bb = ((const float4*)bta)[lane + i * 64];
      float4 o;
      o.x = (v[i].x - mean) * rstd * gg.x + bb.x;
      o.y = (v[i].y - mean) * rstd * gg.y + bb.y;
      o.z = (v[i].z - mean) * rstd * gg.z + bb.z;
      o.w = (v[i].w - mean) * rstd * gg.w + bb.w;
      ((float4*)op)[lane + i * 64] = o;
      if (outb) {
        ushort4 ob;
        ob.x = f2bf(o.x); ob.y = f2bf(o.y); ob.z = f2bf(o.z); ob.w = f2bf(o.w);
        ((ushort4*)(outb + (long)row * 1024))[lane + i * 64] = ob;
      }
    }
  }
}

DEVI float bf2f(u16 v) { return __uint_as_float((unsigned)v << 16); }
struct AttnItem { int g, dil, h, c, l0, qoff; long rbase; };
DEVI AttnItem attn_decode(int item) {
  AttnItem a;
  a.g = item >> 11;
  const int rem = item & 2047;
  a.dil = a.g == 0 ? 1 : (a.g == 1 ? 4 : 16);
  const int nlb = (T / a.dil) >> 6;
  a.h = rem & 7;
  const int cl = rem >> 3;
  a.c = cl / nlb;
  a.l0 = (cl - a.c * nlb) * 64;
  a.qoff = a.g * 512 + a.h * 64;
  a.rbase = (long)a.c * (T / a.dil);
  return a;
}
DEVI void attn_load_qk(const Params& p, const AttnItem& a, uint4& rq0, uint4& rq1, uint4 (&rk)[6]) {
  const int tid = threadIdx.x;
  const u16* __restrict__ Q = p.QKVG;
  {
    const int row = tid >> 3, cc = tid & 7;
    rq0 = *(const uint4*)(Q + ((long)a.g * MP + a.rbase + a.l0 + row) * 512 + a.h * 64 + cc * 8);
    rq1 = *(const uint4*)(Q + ((long)a.g * MP + a.rbase + a.l0 + row + 32) * 512 + a.h * 64 + cc * 8);
  }
#pragma unroll
  for (int i = 0; i < 6; ++i) {
    const int ch = tid + i * 256, row = ch >> 3, cc = ch & 7;
    const int lp = a.l0 - 128 + row;
    rk[i] = make_uint4(0u, 0u, 0u, 0u);
    if (lp >= 0) rk[i] = *(const uint4*)(Q + ((long)(3 + a.g) * MP + a.rbase + lp) * 512 + a.h * 64 + cc * 8);
  }
}
DEVI void attn_load_v(const Params& p, const AttnItem& a, uint4 (&rv)[8]) {
  const int tid = threadIdx.x;
  const u16* __restrict__ Q = p.QKVG;
#pragma unroll
  for (int i = 0; i < 2; ++i) {
    const int task = tid + i * 256, kq = task >> 3, dq = task & 7;
#pragma unroll
    for (int u = 0; u < 4; ++u) {
      const int ki = kq * 4 + u, lp = a.l0 - 128 + ki;
      rv[i * 4 + u] = make_uint4(0u, 0u, 0u, 0u);
      if (task < 416 && ki < 192 && lp >= 0)
        rv[i * 4 + u] = *(const uint4*)(Q + ((long)(6 + a.g) * MP + a.rbase + lp) * 512 + a.h * 64 + dq * 8);
    }
  }
}
DEVI unsigned pk_lo(unsigned a, unsigned b) { return (a & 0xffffu) | (b << 16); }
DEVI unsigned pk_hi(unsigned a, unsigned b) { return (a >> 16) | (b & 0xffff0000u); }
DEVI void attn_store_v(u16* sVt, const uint4 (&rv)[8]) {
  const int tid = threadIdx.x;
#pragma unroll
  for (int i = 0; i < 2; ++i) {
    const int task = tid + i * 256, kq = task >> 3, dq = task & 7;
    if (task < 416) {
      const uint4 v0 = rv[i * 4], v1 = rv[i * 4 + 1], v2 = rv[i * 4 + 2], v3 = rv[i * 4 + 3];
      u16* base = sVt + (dq * 8) * 208 + kq * 4;
      *(uint2*)(base + 0 * 208) = make_uint2(pk_lo(v0.x, v1.x), pk_lo(v2.x, v3.x));
      *(uint2*)(base + 1 * 208) = make_uint2(pk_hi(v0.x, v1.x), pk_hi(v2.x, v3.x));
      *(uint2*)(base + 2 * 208) = make_uint2(pk_lo(v0.y, v1.y), pk_lo(v2.y, v3.y));
      *(uint2*)(base + 3 * 208) = make_uint2(pk_hi(v0.y, v1.y), pk_hi(v2.y, v3.y));
      *(uint2*)(base + 4 * 208) = make_uint2(pk_lo(v0.z, v1.z), pk_lo(v2.z, v3.z));
      *(uint2*)(base + 5 * 208) = make_uint2(pk_hi(v0.z, v1.z), pk_hi(v2.z, v3.z));
      *(uint2*)(base + 6 * 208) = make_uint2(pk_lo(v0.w, v1.w), pk_lo(v2.w, v3.w));
      *(uint2*)(base + 7 * 208) = make_uint2(pk_hi(v0.w, v1.w), pk_hi(v2.w, v3.w));
    }
  }
}

__device__ void attn_prompt_phase(const Params& p, int bid, int nb, char* smem) {
  u16* sQ = (u16*)smem;
  u16* sK = sQ + 64 * 72;
  u16* sVt = sK;
  u16* sP = sK + 192 * 72;
  const int tid = threadIdx.x, lane = tid & 63, w = tid >> 6, lr = lane & 15, lq = lane >> 4;
  uint4 rq0, rq1, rk[6], rv[8];
  { AttnItem a = attn_decode(min(bid, 6143)); attn_load_qk(p, a, rq0, rq1, rk); }
  for (int item = bid; item < 6144; item += nb) {
    const AttnItem a = attn_decode(item);
    __syncthreads();
    *(uint4*)&sQ[(tid >> 3) * 72 + (tid & 7) * 8] = rq0;
    *(uint4*)&sQ[((tid >> 3) + 32) * 72 + (tid & 7) * 8] = rq1;
#pragma unroll
    for (int i = 0; i < 6; ++i) { const int ch = tid + i * 256; *(uint4*)&sK[(ch >> 3) * 72 + (ch & 7) * 8] = rk[i]; }
    __syncthreads();
    attn_load_v(p, a, rv);
    bf16x8 qf[2];
    qf[0] = *(const bf16x8*)&sQ[(w * 16 + lr) * 72 + lq * 8];
    qf[1] = *(const bf16x8*)&sQ[(w * 16 + lr) * 72 + 32 + lq * 8];
    f32x4 s[9];
#pragma unroll
    for (int kt = 0; kt < 9; ++kt) {
      s[kt] = (f32x4){0.f, 0.f, 0.f, 0.f};
#pragma unroll
      for (int ks = 0; ks < 2; ++ks) {
        bf16x8 kf = *(const bf16x8*)&sK[((w + kt) * 16 + lr) * 72 + ks * 32 + lq * 8];
        s[kt] = __builtin_amdgcn_mfma_f32_16x16x32_bf16(qf[ks], kf, s[kt], 0, 0, 0);
      }
    }
    float m[4], sum[4];
#pragma unroll
    for (int j = 0; j < 4; ++j) m[j] = -1e30f;
#pragma unroll
    for (int kt = 0; kt < 9; ++kt) {
      const int lp = a.l0 - 128 + (w + kt) * 16 + lr;
#pragma unroll
      for (int j = 0; j < 4; ++j) {
        const int delta = lq * 4 + j + 128 - kt * 16 - lr;
        const bool valid = (delta >= 0) && (delta <= 128) && (lp >= 0);
        const float v = valid ? s[kt][j] : -1e30f;
        s[kt][j] = v;
        m[j] = fmaxf(m[j], v);
      }
    }
#pragma unroll
    for (int j = 0; j < 4; ++j) m[j] = fmaxf(m[j], dppf<0x128>(m[j]));
#pragma unroll
    for (int j = 0; j < 4; ++j) m[j] = fmaxf(m[j], dppf<0x124>(m[j]));
#pragma unroll
    for (int j = 0; j < 4; ++j) m[j] = fmaxf(m[j], dppf<0x4E>(m[j]));
#pragma unroll
    for (int j = 0; j < 4; ++j) m[j] = fmaxf(m[j], dppf<0xB1>(m[j]));
#pragma unroll
    for (int j = 0; j < 4; ++j) sum[j] = 0.f;
#pragma unroll
    for (int kt = 0; kt < 9; ++kt) {
#pragma unroll
      for (int j = 0; j < 4; ++j) {
        const float pe = s[kt][j] > -1e29f ? __expf(s[kt][j] - m[j]) : 0.f;
        s[kt][j] = pe;
        sum[j] += pe;
      }
    }
#pragma unroll
    for (int j = 0; j < 4; ++j) sum[j] += dppf<0x128>(sum[j]);
#pragma unroll
    for (int j = 0; j < 4; ++j) sum[j] += dppf<0x124>(sum[j]);
#pragma unroll
    for (int j = 0; j < 4; ++j) sum[j] += dppf<0x4E>(sum[j]);
#pragma unroll
    for (int j = 0; j < 4; ++j) sum[j] += dppf<0xB1>(sum[j]);
    u16* wp = sP + w * 16 * 168;
#pragma unroll
    for (int j = 0; j < 4; ++j) {
#pragma unroll
      for (int kt = 0; kt < 9; ++kt) wp[(lq * 4 + j) * 168 + kt * 16 + lr] = f2bf(s[kt][j]);
      wp[(lq * 4 + j) * 168 + 144 + lr] = 0;
    }
    __syncthreads();
    attn_store_v(sVt, rv);
    { AttnItem an = attn_decode(min(item + nb, 6143)); attn_load_qk(p, an, rq0, rq1, rk); }
    __syncthreads();
    f32x4 o[4];
#pragma unroll
    for (int nt = 0; nt < 4; ++nt) o[nt] = (f32x4){0.f, 0.f, 0.f, 0.f};
#pragma unroll
    for (int ks = 0; ks < 5; ++ks) {
      bf16x8 pf = *(const bf16x8*)&wp[lr * 168 + ks * 32 + lq * 8];
#pragma unroll
      for (int nt = 0; nt < 4; ++nt) {
        bf16x8 vf = *(const bf16x8*)&sVt[(nt * 16 + lr) * 208 + w * 16 + ks * 32 + lq * 8];
        o[nt] = __builtin_amdgcn_mfma_f32_16x16x32_bf16(pf, vf, o[nt], 0, 0, 0);
      }
    }
#pragma unroll
    for (int j = 0; j < 4; ++j) {
      long t = (long)(a.l0 + w * 16 + lq * 4 + j) * a.dil + a.c;
      float inv = 1.f / sum[j];
#pragma unroll
      for (int nt = 0; nt < 4; ++nt) p.AO[((long)a.g * MT + t) * 512 + a.h * 64 + nt * 16 + lr] = o[nt][j] * inv;
      if (lr == 0) p.LSE[((long)a.g * MT + t) * 8 + a.h] = m[j] + __logf(sum[j]);
    }
  }
}

DEVI float4 us4_to_f4(ushort4 v) { return make_float4(bf2f(v.x), bf2f(v.y), bf2f(v.z), bf2f(v.w)); }
__device__ void attn_sample_item(const Params& p, int witem, float* sp) {
  const int lane = threadIdx.x & 63, l16 = lane & 15, kq = lane >> 4;
  const int h = witem & 7, g = (witem >> 3) % 3, bs = witem / 24, b = bs >> 2, s = bs & 3;
  const int dil = g == 0 ? 1 : (g == 1 ? 4 : 16);
  const int W = g == 0 ? 128 : (g == 1 ? 512 : 2048);
  const float* cache = g == 0 ? p.cache0 : (g == 1 ? p.cache1 : p.cache2);
  const int row = T + b * 4 + s;
  const float4 q4 = us4_to_f4(*(const ushort4*)(p.QKVG + qs_off(g, row) + h * 64 + l16 * 4));
  const int jstart = g == 0 ? s + 1 : 1;
  for (int j = 0; j < jstart; ++j) {
    const float4 k4 = us4_to_f4(*(const ushort4*)(p.QKVG + qs_off(3 + g, row - dil * j) + h * 64 + l16 * 4));
    const float sc = row16_sum(k4.x * q4.x + k4.y * q4.y + k4.z * q4.z + k4.w * q4.w);
    if (lane == 0) sp[j] = sc;
  }
  const float* cbase = cache + (long)b * W * 1024 + h * 64 + l16 * 4;
#pragma unroll 11
  for (int jj = 0; jj < 33; ++jj) {
    const int j = jstart + jj * 4 + kq, jc = min(j, 128), idx = W + s - dil * jc;
    const float4 k4 = *(const float4*)(cbase + (long)idx * 1024);
    const float sc = row16_sum(k4.x * q4.x + k4.y * q4.y + k4.z * q4.z + k4.w * q4.w);
    if (l16 == 0 && j <= 128) sp[j] = sc;
  }
  __builtin_amdgcn_s_waitcnt(0);
  __builtin_amdgcn_wave_barrier();
  const float a0 = sp[lane], a1 = sp[lane + 64], a2 = lane == 0 ? sp[128] : -1e30f;
  const float mx = wave_max(fmaxf(fmaxf(a0, a1), a2));
  const float e0 = __expf(a0 - mx), e1 = __expf(a1 - mx), e2 = lane == 0 ? __expf(a2 - mx) : 0.f;
  const float sm = wave_sum(e0 + e1 + e2);
  __builtin_amdgcn_wave_barrier();
  sp[lane] = e0; sp[lane + 64] = e1;
  if (lane == 0) sp[128] = e2;
  __builtin_amdgcn_s_waitcnt(0);
  __builtin_amdgcn_wave_barrier();
  float4 acc = make_float4(0.f, 0.f, 0.f, 0.f);
  for (int j = 0; j < jstart; ++j) {
    const float4 v4 = us4_to_f4(*(const ushort4*)(p.QKVG + qs_off(6 + g, row - dil * j) + h * 64 + l16 * 4));
    const float pj = kq == 0 ? sp[j] : 0.f;
    acc.x += pj * v4.x; acc.y += pj * v4.y; acc.z += pj * v4.z; acc.w += pj * v4.w;
  }
#pragma unroll 11
  for (int jj = 0; jj < 33; ++jj) {
    const int j = jstart + jj * 4 + kq, jc = min(j, 128), idx = W + s - dil * jc;
    const float4 v4 = *(const float4*)(cbase + (long)idx * 1024 + 512);
    const float pj = j <= 128 ? sp[jc] : 0.f;
    acc.x += pj * v4.x; acc.y += pj * v4.y; acc.z += pj * v4.z; acc.w += pj * v4.w;
  }
  acc.x += __shfl_xor(acc.x, 16); acc.y += __shfl_xor(acc.y, 16); acc.z += __shfl_xor(acc.z, 16); acc.w += __shfl_xor(acc.w, 16);
  acc.x += __shfl_xor(acc.x, 32); acc.y += __shfl_xor(acc.y, 32); acc.z += __shfl_xor(acc.z, 32); acc.w += __shfl_xor(acc.w, 32);
  const float inv = 1.f / sm;
  if (kq == 0)
    *(float4*)(p.AO + ((long)g * MT + row) * 512 + h * 64 + l16 * 4) = make_float4(acc.x * inv, acc.y * inv, acc.z * inv, acc.w * inv);
  if (lane == 0) p.LSE[((long)g * MT + row) * 8 + h] = mx + __logf(sm);
  __builtin_amdgcn_wave_barrier();
}

__device__ void phaseI(const Params& p, int bid, int nb, char* smem) {
  attn_prompt_phase(p, bid, nb, smem);
  __syncthreads();
  float* sp = (float*)smem + (threadIdx.x >> 6) * 160;
  for (int it = bid * 4 + (threadIdx.x >> 6); it < 3072; it += nb * 4) attn_sample_item(p, it, sp);
}

DEVI float4 bf4_to_f4(uint2 v) {
  return make_float4(__uint_as_float(v.x << 16), __uint_as_float(v.x & 0xffff0000u), __uint_as_float(v.y << 16),
                     __uint_as_float(v.y & 0xffff0000u));
}
__device__ void copy_kv_out(const Params& p, int g, int W, float* kvp, float* kvs, int bid, int nb) {
  const u16* Q = p.QKVG;
  const int np = W * 256;
  const int ns = 32 * 4 * 256;
#pragma unroll 4
  for (int i = bid * 256 + threadIdx.x; i < np + ns; i += nb * 256) {
    if (i < np) {
      int r = i >> 8, rem = i & 255, kv = rem >> 7, c4 = rem & 127;
      ((float4*)kvp)[i] = bf4_to_f4(*(const uint2*)(Q + qs_off(3 + kv * 3 + g, qs_perm(T - W + r, g)) + c4 * 4));
    } else {
      int q = i - np, bs = q >> 8, rem = q & 255, kv = rem >> 7, c4 = rem & 127, b = bs >> 2, s = bs & 3;
      ((float4*)kvs)[((long)(b * W + W - 4 + s) * 2 + kv) * 128 + c4] =
          bf4_to_f4(*(const uint2*)(Q + qs_off(3 + kv * 3 + g, T + bs) + c4 * 4));
    }
  }
}

__device__ void phaseI2(const Params& p, int bid, int nb) {
  const int tid = threadIdx.x;
#pragma unroll 4
  for (int i = bid * 256 + tid; i < MT * 128; i += nb * 256) {
    int row = i >> 7, c4 = i & 127, h = c4 >> 4;
    float l0 = p.LSE[((long)row) * 8 + h], l1 = p.LSE[((long)MT + row) * 8 + h], l2 = p.LSE[((long)2 * MT + row) * 8 + h];
    float mx = fmaxf(l0, fmaxf(l1, l2));
    float e0 = __expf(l0 - mx), e1 = __expf(l1 - mx), e2 = __expf(l2 - mx);
    float inv = 1.f / (e0 + e1 + e2);
    e0 *= inv; e1 *= inv; e2 *= inv;
    float4 a0 = ((const float4*)p.AO)[(long)row * 128 + c4];
    float4 a1 = ((const float4*)p.AO)[((long)MT + row) * 128 + c4];
    float4 a2 = ((const float4*)p.AO)[((long)2 * MT + row) * 128 + c4];
    float4 gt = bf4_to_f4(*(const uint2*)(p.QKVG + qs_off(9, row) + c4 * 4));
    ushort4 ob;
    ob.x = f2bf((e0 * a0.x + e1 * a1.x + e2 * a2.x) * siluf_(gt.x));
    ob.y = f2bf((e0 * a0.y + e1 * a1.y + e2 * a2.y) * siluf_(gt.y));
    ob.z = f2bf((e0 * a0.z + e1 * a1.z + e2 * a2.z) * siluf_(gt.z));
    ob.w = f2bf((e0 * a0.w + e1 * a1.w + e2 * a2.w) * siluf_(gt.w));
    ((ushort4*)p.O2)[(long)row * 128 + c4] = ob;
  }
  copy_kv_out(p, 0, 128, p.kvp0, p.kvs0, bid, nb);
  copy_kv_out(p, 1, 512, p.kvp1, p.kvs1, bid, nb);
  copy_kv_out(p, 2, 2048, p.kvp2, p.kvs2, bid, nb);
}

#define XB_TMO      128
#define XB_XCNT(j)  (256  + 64 * (j))
#define XB_XSUB(j)  (1280 + 64 * (j))
#define XB_XGEN(j)  (2304 + 64 * (j))
#define XB_TOP      3328
#define XB_TOPGEN   3392
#define XCD_BAR_WORDS 3456
#define XB_SPIN_CAP (1u << 18)
#define LAS __attribute__((address_space(3)))

__device__ __forceinline__ unsigned xb_ld(unsigned* p)              { return __hip_atomic_load(p, __ATOMIC_RELAXED, __HIP_MEMORY_SCOPE_AGENT); }
__device__ __forceinline__ unsigned xb_add(unsigned* p, unsigned v) { return __hip_atomic_fetch_add(p, v, __ATOMIC_RELAXED, __HIP_MEMORY_SCOPE_AGENT); }
__device__ __forceinline__ unsigned xb_xcc_id() { return (unsigned)__builtin_amdgcn_s_getreg((3 << 11) | 20) & 0xFu; }
#define XB_SPIN(cond, bar) do { unsigned _sp = 0; while (cond) { __builtin_amdgcn_s_sleep(1); \
    if ((++_sp & 255u) == 0u) { if (xb_ld(&(bar)[XB_TMO])) break; if (_sp > XB_SPIN_CAP) { atomicAdd(&(bar)[XB_TMO], 1u); break; } } } } while (0)

struct XcdBarrier {
    unsigned* bar; unsigned x;
    volatile LAS unsigned* st;
};

__device__ __forceinline__ XcdBarrier xcd_barrier_post(unsigned* bar, volatile LAS unsigned* st) {
    XcdBarrier b; b.bar = bar; b.x = xb_xcc_id(); b.st = st;
    if (threadIdx.x == 0) (void)xb_add(&bar[XB_XCNT(b.x)], 1u);
    return b;
}
__device__ __forceinline__ void xcd_barrier_complete(unsigned* bar, unsigned x, unsigned& nloc, unsigned& nx) {
    const unsigned G = gridDim.x * gridDim.y * gridDim.z;
    unsigned sum, cnt, mine, sp = 0u;
    for (;;) {
        sum = 0u; cnt = 0u; mine = 0u;
#pragma unroll
        for (unsigned j = 0; j < 16; ++j) { const unsigned c = xb_ld(&bar[XB_XCNT(j)]); sum += c; cnt += (c > 0u) ? 1u : 0u; mine = (j == x) ? c : mine; }
        if (sum == G) break;
        __builtin_amdgcn_s_sleep(1);
        if ((++sp & 255u) == 0u) { if (xb_ld(&bar[XB_TMO])) break; if (sp > XB_SPIN_CAP) { atomicAdd(&bar[XB_TMO], 1u); break; } }
    }
    nloc = mine > 0u ? mine : 1u; nx = cnt > 0u ? cnt : 1u;
}

__device__ __forceinline__ void xcd_barrier(const XcdBarrier& b) {
    asm volatile("s_waitcnt vmcnt(0)" ::: "memory");
    __syncthreads();
    if (threadIdx.x == 0) {
        unsigned* bar = b.bar;
        __builtin_amdgcn_s_waitcnt(0);
        unsigned nloc = b.st[0], nx = b.st[1];
        if (nloc == 0u) { xcd_barrier_complete(bar, b.x, nloc, nx); b.st[0] = nloc; b.st[1] = nx; }
        const unsigned old = xb_add(&bar[XB_XSUB(b.x)], 1u);
        const unsigned gen = old / nloc;
        if (old + 1u == (gen + 1u) * nloc) {
            __builtin_amdgcn_fence(__ATOMIC_RELEASE, "agent");
            asm volatile("s_waitcnt vmcnt(0)" ::: "memory");
            const unsigned og = xb_add(&bar[XB_TOP], 1u);
            const unsigned tg = og / nx;
            if (og + 1u == (tg + 1u) * nx) xb_add(&bar[XB_TOPGEN], 1u);
            else XB_SPIN(xb_ld(&bar[XB_TOPGEN]) == tg, bar);
            __builtin_amdgcn_fence(__ATOMIC_ACQUIRE, "agent");
            xb_add(&bar[XB_XGEN(b.x)], 1u);
            asm volatile("s_waitcnt vmcnt(0)" ::: "memory");
        } else {
            XB_SPIN(xb_ld(&bar[XB_XGEN(b.x)]) == gen, bar);
            __builtin_amdgcn_fence(__ATOMIC_ACQUIRE, "agent");
            asm volatile("s_waitcnt vmcnt(0)" ::: "memory");
        }
    }
    __syncthreads();
}


template <int PH> DEVI void run_phase(const Params& p, int bid, int nb, char* smem) {
  if (PH == 0) phaseA(p, bid, nb, smem);
  if (PH == 1) gemm_big<0>(p.Xb, p.WinE, 1024, 65, 29, p.P, ECP, bid, nb, smem);
  if (PH == 2) phaseC(p, bid, nb, smem);
  if (PH == 3) phaseD1(p, bid, nb, smem);
  if (PH == 4) phaseD2(p, bid, nb, smem);
  if (PH == 5) { phaseD3(p, bid, nb, smem); conv_state_out(p, bid, nb); }
  if (PH == 6) gemm_phase<0>(p.Y, p.WoutE, 1024, 129, 8, p.Z, 1024, nullptr, nullptr, bid, nb, smem);
  if (PH == 7) ln_phase(p.Z, p.x_prompt, p.x_sample, p.ln_g, p.ln_b, p.X1, p.X1 + (long)T * 1024, p.X1b, bid, nb);
  if (PH == 8) gemm_big<2>(p.X1b, p.WinO, 1024, 65, 40, (float*)p.QKVG, OC, bid, nb, smem);
  if (PH == 9) phaseI(p, bid, nb, smem);
  if (PH == 10) phaseI2(p, bid, nb);
  if (PH == 11) gemm_phase<0>(p.O2, p.WoutO, 512, 129, 8, p.Z, 1024, nullptr, nullptr, bid, nb, smem);
  if (PH == 12) ln_phase(p.Z, p.X1, p.X1 + (long)T * 1024, p.ln_g + 1024, p.ln_b + 1024, p.y_prompt, p.y_sample, nullptr, bid, nb);
}
constexpr int NPH = 13;
template <int PH> DEVI void run_all(const Params& p, int bid, int nb, char* smem, const XcdBarrier& xb) {
  run_phase<PH>(p, bid, nb, smem);
  if constexpr (((REPMASK) >> PH) & 1) { xcd_barrier(xb); run_phase<PH>(p, bid, nb, smem); }
  if constexpr (PH + 1 < NPH) { xcd_barrier(xb); run_all<PH + 1>(p, bid, nb, smem, xb); }
}

#if MEGA
__global__ void __launch_bounds__(256, 2) mega_kernel(Params p) {
  __shared__ __attribute__((aligned(16))) char smem[SMEM_BYTES];
  __shared__ uint4 xb_words;
  const int bid = blockIdx.x, nb = gridDim.x;
  if (threadIdx.x == 0) xb_words = make_uint4(0u, 0u, 0u, 0u);
  __syncthreads();
  XcdBarrier xb = xcd_barrier_post(p.bar, (volatile LAS unsigned*)&xb_words);
  if (p.bar == nullptr) cg::this_grid().sync();
#ifdef XSYNC
  for (int i = 0; i < XSYNC; ++i) xcd_barrier(xb);
#endif
  run_all<0>(p, bid, nb, smem, xb);
}
#else
template <int PH> __global__ void __launch_bounds__(256, 2) phase_kernel(Params p) {
  __shared__ __attribute__((aligned(16))) char smem[SMEM_BYTES];
  run_phase<PH>(p, blockIdx.x, gridDim.x, smem);
}
#endif

extern "C" void kernel_launch(void* const* d_in, const int* in_sizes, int n_in, void* d_out, int out_size,
                              void* d_ws, size_t ws_size, hipStream_t stream) {
  Params p{};
  const float** ins = (const float**)&p.x_prompt;
  for (int i = 0; i < 28; ++i) ins[i] = (const float*)d_in[i];
  float* o = (float*)d_out;
  p.y_prompt = o; o += 16777216;
  p.y_sample = o; o += 131072;
  p.conv_p = o; o += 15360;
  p.conv_s = o; o += 491520;
  p.shift_p = o; o += 1024;
  p.shift_s = o; o += 32768;
  p.wkv_p = o; o += 32768;
  p.wkv_s = o; o += 1048576;
  p.kvp0 = o; o += 131072;
  p.kvs0 = o; o += 4194304;
  p.kvp1 = o; o += 524288;
  p.kvs1 = o; o += 16777216;
  p.kvp2 = o; o += 2097152;
  p.kvs2 = o; o += 67108864;
  char* w = (char*)d_ws;
  size_t off = 0;
  auto take = [&](size_t bytes) { char* r = w + off; off += (bytes + 255) & ~(size_t)255; return r; };
  p.Xb = (u16*)take((size_t)MP * 1024 * 2);
  p.WinE = (u16*)take((size_t)ECP * 1024 * 2);
  p.WoutE = (u16*)take((size_t)1024 * 1024 * 2);
  p.WinO = (u16*)take((size_t)OC * 1024 * 2);
  p.WoutO = (u16*)take((size_t)1024 * 512 * 2);
  p.Y = (u16*)take((size_t)MP * 1024 * 2);
  p.X1b = (u16*)take((size_t)MP * 1024 * 2);
  p.O2 = (u16*)take((size_t)MP * 512 * 2);
  p.Z = (float*)take((size_t)MP * 1024 * 4);
  p.X1 = (float*)take((size_t)MP * 1024 * 4);
  size_t offB = off;
  p.P = (float*)take((size_t)MP * ECP * 4);
  p.scan = (float*)take((size_t)6 * SCAN_STRIDE * 4);
  p.U = (float*)take((size_t)(SCAN_STRIDE + 30 * 512) * 4) + 30 * 512;
  p.Oraw = (float*)take((size_t)SCAN_STRIDE * 4);
  p.Gbuf = (float*)take((size_t)8 * NCH * 4096 * 4);
  p.Hbuf = (float*)take((size_t)8 * NCH * 4096 * 4);
  p.Sst = (float*)take((size_t)8 * NCH * 4096 * 4);
  off = offB;
  p.QKVG = (u16*)take((size_t)MP * OC * 2);
  p.AO = (float*)take((size_t)3 * SCAN_STRIDE * 4);
  p.LSE = (float*)take((size_t)3 * MT * 8 * 4);
  off = (size_t)900 << 20;
  p.bar = (unsigned*)take((size_t)XCD_BAR_WORDS * 4);
#if MEGA
  static int grid_blocks = 0;
  if (!grid_blocks) {
    int dev = 0, cus = 0, per_cu = 0;
    hipGetDevice(&dev);
    hipDeviceGetAttribute(&cus, hipDeviceAttributeMultiprocessorCount, dev);
    hipOccupancyMaxActiveBlocksPerMultiprocessor(&per_cu, mega_kernel, 256, 0);
    if (per_cu > 2) per_cu = 2;
    grid_blocks = cus * per_cu;
  }
  hipMemsetAsync(p.bar, 0, (size_t)XCD_BAR_WORDS * 4, stream);
  void* args[] = {&p};
  hipError_t e = hipLaunchCooperativeKernel((void*)mega_kernel, dim3(grid_blocks), dim3(256), args, 0, stream);
  if (e != hipSuccess) fprintf(stderr, "cooperative launch failed: %s (grid %d)\n", hipGetErrorString(e), grid_blocks);
#else
  const int G = 1024;
  phase_kernel<0><<<G, 256, 0, stream>>>(p);
  phase_kernel<1><<<G, 256, 0, stream>>>(p);
  phase_kernel<2><<<G, 256, 0, stream>>>(p);
  phase_kernel<3><<<G, 256, 0, stream>>>(p);
  phase_kernel<4><<<G, 256, 0, stream>>>(p);
  phase_kernel<5><<<G, 256, 0, stream>>>(p);
  phase_kernel<6><<<G, 256, 0, stream>>>(p);
  phase_kernel<7><<<G, 256, 0, stream>>>(p);
  phase_kernel<8><<<G, 256, 0, stream>>>(p);
  phase_kernel<9><<<G, 256, 0, stream>>>(p);
  phase_kernel<10><<<G, 256, 0, stream>>>(p);
  phase_kernel<11><<<G, 256, 0, stream>>>(p);
  phase_kernel<12><<<G, 256, 0, stream>>>(p);
#endif
}
```

```cpp
#include <hip/hip_runtime.h>
#include <hip/hip_bf16.h>
#include <hip/hip_cooperative_groups.h>
#include <cstdio>
namespace cg = cooperative_groups;

#ifndef MEGA
#define MEGA 1
#endif
#ifndef REPMASK
#define REPMASK 0
#endif

typedef __attribute__((ext_vector_type(8))) short bf16x8;
typedef __attribute__((ext_vector_type(4))) float f32x4;
typedef unsigned short u16;
#define DEVI __device__ __forceinline__

constexpr int T = 16384;
constexpr int NS = 128;
constexpr int MT = T + NS;
constexpr int MX = MT + 32;
constexpr int MP = 16640;
constexpr int EC = 3648, ECP = 3712, OC = 5120;
constexpr float ALPHA = 1.41421356237f;
constexpr int SCAN_STRIDE = MT * 512;
constexpr int SMEM_BYTES = 61440;

struct Params {
  const float *x_prompt, *x_sample, *state_conv, *state_shift, *state_wkv, *cache0, *cache1, *cache2;
  const float *w_in_even, *conv_w, *conv_b, *cln_g, *cln_b, *mu, *w0, *w2, *a0, *a2, *k_k, *k_a, *r_k,
      *lnx_g, *lnx_b, *w_out_even, *w_in_odd, *w_out_odd, *ln_g, *ln_b;
  float *y_prompt, *y_sample, *conv_p, *conv_s, *shift_p, *shift_s, *wkv_p, *wkv_s, *kvp0, *kvs0, *kvp1, *kvs1,
      *kvp2, *kvs2;
  u16 *Xb, *WinE, *WoutE, *WinO, *WoutO, *Y, *X1b, *O2;
  float *Z, *X1, *P, *scan, *U, *Oraw, *AO, *LSE, *Gbuf, *Hbuf, *Sst;
  u16* QKVG;
  unsigned* bar;
};

DEVI u16 f2bf(float f) {
  unsigned u = __float_as_uint(f);
  u += 0x7fffu + ((u >> 16) & 1u);
  return (u16)(u >> 16);
}
template <int CTRL> DEVI float dppf(float x) {
  return __builtin_bit_cast(float, __builtin_amdgcn_mov_dpp(__builtin_bit_cast(int, x), CTRL, 0xf, 0xf, true));
}
DEVI float row16_sum(float x) {
  x += dppf<0x128>(x);
  x += dppf<0x124>(x);
  x += dppf<0x4E>(x);
  x += dppf<0xB1>(x);
  return x;
}
DEVI float row16_max(float x) {
  x = fmaxf(x, dppf<0x128>(x));
  x = fmaxf(x, dppf<0x124>(x));
  x = fmaxf(x, dppf<0x4E>(x));
  x = fmaxf(x, dppf<0xB1>(x));
  return x;
}
DEVI float wave_sum(float v) {
  v = row16_sum(v);
  v += __shfl_xor(v, 16);
  v += __shfl_xor(v, 32);
  return v;
}
DEVI float wave_max(float v) {
  v = row16_max(v);
  v = fmaxf(v, __shfl_xor(v, 16));
  v = fmaxf(v, __shfl_xor(v, 32));
  return v;
}
DEVI float frcp(float x) { return __builtin_amdgcn_rcpf(x); }
DEVI float sigmoidf_(float x) { return frcp(1.f + __expf(-x)); }
DEVI float siluf_(float x) { return x * frcp(1.f + __expf(-x)); }
DEVI int prev_row(int row) {
  if (row < T) return row - 1;
  int q = row - T;
  if (q & 3) return row - 1;
  return MT + (q >> 2);
}

__device__ void transpose_tile(const float* __restrict__ W, u16* __restrict__ Wt, int K, int N, int tk, int tn,
                               float* lds) {
  const int tid = threadIdx.x;
  const int k0 = tk * 64, n0 = tn * 64;
  __syncthreads();
  for (int e = tid; e < 4096; e += 256) {
    int kk = e >> 6, nn = e & 63;
    int n = n0 + nn;
    lds[kk * 65 + nn] = (n < N) ? W[(long)(k0 + kk) * N + n] : 0.f;
  }
  __syncthreads();
  for (int e = tid; e < 4096; e += 256) {
    int nn = e >> 6, kk = e & 63;
    Wt[(long)(n0 + nn) * K + k0 + kk] = f2bf(lds[kk * 65 + nn]);
  }
}

template <int W>
__device__ void copy_cache(const float* __restrict__ src, float* __restrict__ dst, int bid, int nb) {
  constexpr int per_b = (W - 4) * 256;
  constexpr int total = 32 * per_b;
  const f32x4* s4 = (const f32x4*)src;
  f32x4* d4 = (f32x4*)dst;
  const int stride = nb * 256;
  for (int i = bid * 256 + threadIdx.x; i < total; i += 4 * stride) {
    f32x4 v[4];
    int o[4];
#pragma unroll
    for (int k = 0; k < 4; ++k) {
      const int idx = i + k * stride;
      const int ii = min(idx, total - 1);
      const int b = ii / per_b, rem = ii - b * per_b;
      o[k] = idx < total ? b * (W * 256) + rem : -1;
      v[k] = __builtin_nontemporal_load(&s4[b * (W * 256) + rem + 1024]);
    }
#pragma unroll
    for (int k = 0; k < 4; ++k)
      if (o[k] >= 0) __builtin_nontemporal_store(v[k], &d4[o[k]]);
  }
}

__device__ void phaseA(const Params& p, int bid, int nb, char* smem) {
  const int tid = threadIdx.x;
  {
    const long total = (long)MP * 256;
#pragma unroll 4
    for (long i = (long)bid * 256 + tid; i < total; i += (long)nb * 256) {
      int row = (int)(i >> 8), c4 = (int)(i & 255);
      float4 v = make_float4(0.f, 0.f, 0.f, 0.f);
      if (row < T) v = ((const float4*)p.x_prompt)[(long)row * 256 + c4];
      else if (row < MT) v = ((const float4*)p.x_sample)[(long)(row - T) * 256 + c4];
      else if (row < MX) v = ((const float4*)p.state_shift)[(long)(row - MT) * 256 + c4];
      ushort4 o;
      o.x = f2bf(v.x); o.y = f2bf(v.y); o.z = f2bf(v.z); o.w = f2bf(v.w);
      ((ushort4*)p.Xb)[i] = o;
    }
  }
  {
    const int n0 = 16 * 58, n1 = n0 + 16 * 16, n2 = n1 + 16 * 80, n3 = n2 + 8 * 16;
    for (int t = bid; t < n3; t += nb) {
      if (t < n0) transpose_tile(p.w_in_even, p.WinE, 1024, EC, t % 16, t / 16, (float*)smem);
      else if (t < n1) transpose_tile(p.w_out_even, p.WoutE, 1024, 1024, (t - n0) % 16, (t - n0) / 16, (float*)smem);
      else if (t < n2) transpose_tile(p.w_in_odd, p.WinO, 1024, OC, (t - n1) % 16, (t - n1) / 16, (float*)smem);
      else transpose_tile(p.w_out_odd, p.WoutO, 512, 1024, (t - n2) % 8, (t - n2) / 8, (float*)smem);
    }
  }
  for (int i = bid * 256 + tid; i < 30 * 512; i += nb * 256) p.U[i - 30 * 512] = 0.f;
  for (int i = bid * 256 + tid; i < 1024 + 32 * 1024; i += nb * 256) {
    if (i < 1024) p.shift_p[i] = p.x_prompt[(long)(T - 1) * 1024 + i];
    else {
      int q = i - 1024, b = q >> 10, c = q & 1023;
      p.shift_s[q] = p.x_sample[(long)(b * 4 + 3) * 1024 + c];
    }
  }
}

DEVI int qs_perm(int t, int g) {
  const int lg = g * 2;
  return t < T ? (t & ((1 << lg) - 1)) * (T >> lg) + (t >> lg) : t;
}
DEVI long qs_off(int sec, int row) { return ((long)sec * MP + row) * 512; }
template <int EPI>
__device__ void gemm_phase(const u16* __restrict__ A, const u16* __restrict__ Bt, int K, int nM, int nN,
                           float* __restrict__ C, int ldc, const float* __restrict__ res0,
                           const float* __restrict__ res1, int bid, int nb, char* smem) {
  u16* sA = (u16*)smem;
  u16* sB = sA + 2 * 5120;
  const int tid = threadIdx.x, lane = tid & 63, w = tid >> 6, wm = w >> 1, wn = w & 1;
  const int lr = lane & 15, lq = lane >> 4;
  const int ntiles = nM * nN, nk = K / 32;
  const int r0 = tid >> 2, kc = tid & 3;
  const int so0 = r0 * 40 + kc * 8, so1 = so0 + 64 * 40;
  for (int tile = bid; tile < ntiles; tile += nb) {
    int nig = 8 * nN, gid = tile / nig, fm = gid * 8, gsz = min(nM - fm, 8);
    int tm = fm + ((tile % nig) % gsz), tn = (tile % nig) / gsz;
    const u16* a0p = A + (long)(tm * 128 + r0) * K + kc * 8;
    const u16* a1p = a0p + 64L * K;
    const u16* b0p = Bt + (long)(tn * 128 + r0) * K + kc * 8;
    const u16* b1p = b0p + 64L * K;
    uint4 ea0 = *(const uint4*)a0p, ea1 = *(const uint4*)a1p, eb0 = *(const uint4*)b0p, eb1 = *(const uint4*)b1p;
    uint4 oa0 = *(const uint4*)(a0p + 32), oa1 = *(const uint4*)(a1p + 32), ob0 = *(const uint4*)(b0p + 32),
          ob1 = *(const uint4*)(b1p + 32);
    f32x4 acc[4][4];
#pragma unroll
    for (int mi = 0; mi < 4; ++mi)
#pragma unroll
      for (int ni = 0; ni < 4; ++ni) acc[mi][ni] = (f32x4){0.f, 0.f, 0.f, 0.f};
    __syncthreads();
    *(uint4*)&sA[so0] = ea0; *(uint4*)&sA[so1] = ea1; *(uint4*)&sB[so0] = eb0; *(uint4*)&sB[so1] = eb1;
    __syncthreads();
    auto compute = [&](int buf) {
      const u16* cA = sA + buf * 5120;
      const u16* cB = sB + buf * 5120;
      bf16x8 af[4], bfr[4];
#pragma unroll
      for (int mi = 0; mi < 4; ++mi) af[mi] = *(const bf16x8*)&cA[(wm * 64 + mi * 16 + lr) * 40 + lq * 8];
#pragma unroll
      for (int ni = 0; ni < 4; ++ni) bfr[ni] = *(const bf16x8*)&cB[(wn * 64 + ni * 16 + lr) * 40 + lq * 8];
#pragma unroll
      for (int mi = 0; mi < 4; ++mi)
#pragma unroll
        for (int ni = 0; ni < 4; ++ni)
          acc[mi][ni] = __builtin_amdgcn_mfma_f32_16x16x32_bf16(af[mi], bfr[ni], acc[mi][ni], 0, 0, 0);
    };
    for (int kt = 0; kt < nk; kt += 2) {
      {
        const int kn = min(kt + 2, nk - 1) * 32;
        ea0 = *(const uint4*)(a0p + kn); ea1 = *(const uint4*)(a1p + kn);
        eb0 = *(const uint4*)(b0p + kn); eb1 = *(const uint4*)(b1p + kn);
      }
      __builtin_amdgcn_sched_barrier(0);
      compute(0);
      __builtin_amdgcn_sched_barrier(0);
      *(uint4*)&sA[5120 + so0] = oa0; *(uint4*)&sA[5120 + so1] = oa1;
      *(uint4*)&sB[5120 + so0] = ob0; *(uint4*)&sB[5120 + so1] = ob1;
      __syncthreads();
      {
        const int kn = min(kt + 3, nk - 1) * 32;
        oa0 = *(const uint4*)(a0p + kn); oa1 = *(const uint4*)(a1p + kn);
        ob0 = *(const uint4*)(b0p + kn); ob1 = *(const uint4*)(b1p + kn);
      }
      __builtin_amdgcn_sched_barrier(0);
      compute(1);
      __builtin_amdgcn_sched_barrier(0);
      *(uint4*)&sA[so0] = ea0; *(uint4*)&sA[so1] = ea1; *(uint4*)&sB[so0] = eb0; *(uint4*)&sB[so1] = eb1;
      __syncthreads();
    }
#pragma unroll
    for (int mi = 0; mi < 4; ++mi) {
#pragma unroll
      for (int j = 0; j < 4; ++j) {
        const int row = tm * 128 + wm * 64 + mi * 16 + lq * 4 + j;
        const int col = tn * 128 + wn * 64 + lr;
        float* cp = C + (long)row * ldc + col;
        if (EPI == 2) {
          u16* cb = (u16*)C + (long)row * ldc + col;
          const float sc = (tn * 128 < 1536) ? 0.125f : 1.f;
#pragma unroll
          for (int ni = 0; ni < 4; ++ni) cb[ni * 16] = f2bf(acc[mi][ni][j] * sc);
        } else if (EPI == 1) {
          const float* rp = (row < T ? res0 + (long)row * 1024 : res1 + (long)(row - T) * 1024) + col;
#pragma unroll
          for (int ni = 0; ni < 4; ++ni) cp[ni * 16] = acc[mi][ni][j] + ALPHA * rp[ni * 16];
        } else {
#pragma unroll
          for (int ni = 0; ni < 4; ++ni) cp[ni * 16] = acc[mi][ni][j];
        }
      }
      asm volatile("" ::: "memory");
    }
  }
}

template <int EPI>
__device__ void gemm_big(const u16* __restrict__ A, const u16* __restrict__ Bt, int K, int nM, int nN,
                         float* __restrict__ C, int ldc, int bid, int nb, char* smem) {
  u16* sA = (u16*)smem;
  u16* sB = sA + 2 * 10240;
  const int tid = threadIdx.x, lane = tid & 63, w = tid >> 6, wm = w >> 1, wn = w & 1;
  const int lr = lane & 15, lq = lane >> 4;
  const int ntiles = nM * nN, nk = K / 32;
  const int r0 = tid >> 2, kc = tid & 3;
  const int so = r0 * 40 + kc * 8;
  for (int tile = bid; tile < ntiles; tile += nb) {
    int nig = 8 * nN, gid = tile / nig, fm = gid * 8, gsz = min(nM - fm, 8);
    int tm = fm + ((tile % nig) % gsz), tn = (tile % nig) / gsz;
    const u16* ap = A + (long)(tm * 256 + r0) * K + kc * 8;
    const u16* bp = Bt + (long)(tn * 128 + r0) * K + kc * 8;
    uint4 ra0 = *(const uint4*)ap, ra1 = *(const uint4*)(ap + 64L * K), ra2 = *(const uint4*)(ap + 128L * K),
          ra3 = *(const uint4*)(ap + 192L * K);
    uint4 rb0 = *(const uint4*)bp, rb1 = *(const uint4*)(bp + 64L * K);
    f32x4 acc[8][4];
#pragma unroll
    for (int mi = 0; mi < 8; ++mi)
#pragma unroll
      for (int ni = 0; ni < 4; ++ni) acc[mi][ni] = (f32x4){0.f, 0.f, 0.f, 0.f};
    __syncthreads();
    *(uint4*)&sA[so] = ra0; *(uint4*)&sA[so + 2560] = ra1; *(uint4*)&sA[so + 5120] = ra2; *(uint4*)&sA[so + 7680] = ra3;
    *(uint4*)&sB[so] = rb0; *(uint4*)&sB[so + 2560] = rb1;
    __syncthreads();
    for (int kt = 0; kt < nk; ++kt) {
      const int buf = kt & 1;
      {
        const int kn = min(kt + 1, nk - 1) * 32;
        ra0 = *(const uint4*)(ap + kn); ra1 = *(const uint4*)(ap + 64L * K + kn);
        ra2 = *(const uint4*)(ap + 128L * K + kn); ra3 = *(const uint4*)(ap + 192L * K + kn);
        rb0 = *(const uint4*)(bp + kn); rb1 = *(const uint4*)(bp + 64L * K + kn);
      }
      __builtin_amdgcn_sched_barrier(0);
      const u16* cA = sA + buf * 10240;
      const u16* cB = sB + buf * 5120;
      bf16x8 bfr[4];
#pragma unroll
      for (int ni = 0; ni < 4; ++ni) bfr[ni] = *(const bf16x8*)&cB[(wn * 64 + ni * 16 + lr) * 40 + lq * 8];
      bf16x8 afr[8];
#pragma unroll
      for (int mi = 0; mi < 8; ++mi) afr[mi] = *(const bf16x8*)&cA[(wm * 128 + mi * 16 + lr) * 40 + lq * 8];
      __builtin_amdgcn_s_setprio(1);
#pragma unroll
      for (int mi = 0; mi < 8; ++mi) {
#pragma unroll
        for (int ni = 0; ni < 4; ++ni)
          acc[mi][ni] = __builtin_amdgcn_mfma_f32_16x16x32_bf16(afr[mi], bfr[ni], acc[mi][ni], 0, 0, 0);
      }
      __builtin_amdgcn_s_setprio(0);
      __builtin_amdgcn_sched_barrier(0);
      {
        u16* nA = sA + (buf ^ 1) * 10240;
        u16* nB = sB + (buf ^ 1) * 5120;
        *(uint4*)&nA[so] = ra0; *(uint4*)&nA[so + 2560] = ra1; *(uint4*)&nA[so + 5120] = ra2; *(uint4*)&nA[so + 7680] = ra3;
        *(uint4*)&nB[so] = rb0; *(uint4*)&nB[so + 2560] = rb1;
      }
      __syncthreads();
    }
#pragma unroll
    for (int mi = 0; mi < 8; ++mi) {
#pragma unroll
      for (int j = 0; j < 4; ++j) {
        const int row = tm * 256 + wm * 128 + mi * 16 + lq * 4 + j;
        const int col = tn * 128 + wn * 64 + lr;
        if (EPI == 2) {
          const int sec = tn >> 2;
          const int orow = sec < 9 ? qs_perm(row, sec % 3) : row;
          u16* cb = (u16*)C + qs_off(sec, orow) + (tn & 3) * 128 + wn * 64 + lr;
          const float sc = (tn * 128 < 1536) ? 0.125f : 1.f;
#pragma unroll
          for (int ni = 0; ni < 4; ++ni) cb[ni * 16] = f2bf(acc[mi][ni][j] * sc);
        } else {
          float* cp = C + (long)row * ldc + col;
#pragma unroll
          for (int ni = 0; ni < 4; ++ni) cp[ni * 16] = acc[mi][ni][j];
        }
      }
      asm volatile("" ::: "memory");
    }
  }
}

__device__ void phaseC(const Params& p, int bid, int nb, char* smem) {
  float* lwd = (float*)smem;
  float* lad = lwd + 256;
  const int tid = threadIdx.x;
  const float* __restrict__ P = p.P;
#pragma unroll 1
  for (int half = 0; half < 2; ++half) {
    const int c = tid + half * 256;
    float w2c[32], a2c[32];
#pragma unroll
    for (int l = 0; l < 32; ++l) { w2c[l] = p.w2[l * 512 + c]; a2c[l] = p.a2[l * 512 + c]; }
    const float w0c = p.w0[c], a0c = p.a0[c];
    const float mur = p.mu[c], muk = p.mu[512 + c], muv = p.mu[1024 + c];
    const float kkc = p.k_k[c], kac = p.k_a[c];
    const float mwa = p.mu[1536 + (tid & 63)];
    for (int it = bid; it < MT / 8; it += nb) {
      const int row0 = it * 8;
      __syncthreads();
#pragma unroll
      for (int e = tid; e < 512; e += 256) {
        int r = e >> 6, cc = e & 63;
        int row = row0 + r, prow = prev_row(row);
        float cur = P[(long)row * ECP + 1536 + cc];
        float prv = prow >= 0 ? P[(long)prow * ECP + 1536 + cc] : 0.f;
        float val = cur + (prv - cur) * mwa;
        if (cc < 32) lwd[r * 32 + cc] = 1.f - 2.f * frcp(1.f + __expf(2.f * val));
        else lad[r * 32 + cc - 32] = val;
      }
      __syncthreads();
      float cum = 1.f;
#pragma unroll 4
      for (int r = 0; r < 8; ++r) {
        const int row = row0 + r, prow = prev_row(row);
        const float* pc = P + (long)row * ECP;
        const float cr = pc[c], ck = pc[512 + c], cv = pc[1024 + c], cval = pc[1600 + c], cglu = pc[2112 + c];
        float pr = 0.f, pk = 0.f, pv = 0.f;
        if (prow >= 0) { const float* pp = P + (long)prow * ECP; pr = pp[c]; pk = pp[512 + c]; pv = pp[1024 + c]; }
        float aw = w0c, aa = a0c;
#pragma unroll
        for (int l4 = 0; l4 < 8; ++l4) {
          const float4 x = *(const float4*)&lwd[r * 32 + l4 * 4];
          const float4 y = *(const float4*)&lad[r * 32 + l4 * 4];
          aw += x.x * w2c[l4 * 4] + x.y * w2c[l4 * 4 + 1] + x.z * w2c[l4 * 4 + 2] + x.w * w2c[l4 * 4 + 3];
          aa += y.x * a2c[l4 * 4] + y.y * a2c[l4 * 4 + 1] + y.z * a2c[l4 * 4 + 2] + y.w * a2c[l4 * 4 + 3];
        }
        float rr = cr + (pr - cr) * mur, kx = ck + (pk - ck) * muk, vv = cv + (pv - cv) * muv;
        float z = -aw;
        float sp = fmaxf(z, 0.f) + __logf(1.f + __expf(-fabsf(z)));
        float decay = __expf(-__expf(-sp - 0.5f));
        float a = sigmoidf_(aa);
        float kkv = kx * kkc;
        float ss = wave_sum(kkv * kkv);
        kkv = kkv * fminf(__builtin_amdgcn_rsqf(ss), 1e12f);
        float kmod = kx * (1.f + (a - 1.f) * kac);
        const float cprev = (r == 0 || (r == 4 && row0 >= T)) ? 1.f : cum;
        cum = cprev * decay;
        const float cinv = frcp(cum);
        float* so = p.scan + (long)row * 3072 + c;
        so[0] = rr * cum;
        so[512] = cum;
        so[1024] = kmod * cinv;
        so[1536] = vv;
        so[2048] = kkv * cprev;
        so[2560] = -(kkv * a) * cinv;
        p.U[(long)row * 512 + c] = cval * sigmoidf_(cglu);
      }
    }
  }
}

typedef float f2 __attribute__((ext_vector_type(2)));
constexpr int CH = 256;
constexpr int NCH = T / CH;
DEVI float row8_sum(float x) {
  x += dppf<0x141>(x);
  x += dppf<0x4E>(x);
  x += dppf<0xB1>(x);
  return x;
}
template <int R, bool P1>
__device__ void scan_chunk(const Params& p, int h, int row0, int nsteps, const float* __restrict__ init,
                           float* __restrict__ fin0, float* __restrict__ fin1, char* smem) {
  constexpr bool OUT = !P1;
  float* buf = (float*)smem;
  const int tid = threadIdx.x, lane = tid & 63, w = tid >> 6, cg = lane & 7, rg = lane >> 3;
  const int rowb = w * 8 * R + rg * R, j0 = cg * 8;
  const bool isG = P1 && (rowb >= 64);
  const int ib = rowb & 63;
  f2 S[R][4];
#pragma unroll
  for (int rr = 0; rr < R; ++rr) {
    if (!P1) {
      float4 t0 = *(const float4*)(init + (ib + rr) * 64 + j0), t1 = *(const float4*)(init + (ib + rr) * 64 + j0 + 4);
      S[rr][0] = (f2){t0.x, t0.y}; S[rr][1] = (f2){t0.z, t0.w};
      S[rr][2] = (f2){t1.x, t1.y}; S[rr][3] = (f2){t1.z, t1.w};
    } else {
      int d = isG ? ib + rr - j0 : -1;
#pragma unroll
      for (int q = 0; q < 4; ++q) S[rr][q] = (f2){d == 2 * q ? 1.f : 0.f, d == 2 * q + 1 ? 1.f : 0.f};
    }
  }
  const int nch = (nsteps + 15) >> 4;
  const float* __restrict__ sc = p.scan;
  float4 pre[6];
  __syncthreads();
#pragma unroll
  for (int q = 0; q < 6; ++q) {
    int e = tid + q * 256, st = e / 96, rem = e - st * 96, a = rem >> 4, f4 = rem & 15;
    pre[q] = make_float4(0.f, 0.f, 0.f, 0.f);
    if (st < nsteps) pre[q] = *(const float4*)(sc + (long)(row0 + st) * 3072 + a * 512 + h * 64 + f4 * 4);
  }
#pragma unroll
  for (int q = 0; q < 6; ++q) *(float4*)(buf + (tid + q * 256) * 4) = pre[q];
  __syncthreads();
  for (int c = 0; c < nch; ++c) {
    const int s0 = c * 16;
    const int n = min(16, nsteps - s0);
    if (c + 1 < nch) {
#pragma unroll
      for (int q = 0; q < 6; ++q) {
        int e = tid + q * 256, st = e / 96, rem = e - st * 96, a = rem >> 4, f4 = rem & 15;
        int gs = s0 + 16 + st;
        pre[q] = make_float4(0.f, 0.f, 0.f, 0.f);
        if (gs < nsteps) pre[q] = *(const float4*)(sc + (long)(row0 + gs) * 3072 + a * 512 + h * 64 + f4 * 4);
      }
    }
    const float* cb = buf + (c & 1) * 6144;
#pragma unroll 2
    for (int s = 0; s < n; ++s) {
      const float* L = cb + s * 384;
      f2 kv[4], kkv[4], nbv[4], rv[4];
      {
        const float4 a = *(const float4*)(L + 128 + j0), b = *(const float4*)(L + 128 + j0 + 4);
        kv[0] = (f2){a.x, a.y}; kv[1] = (f2){a.z, a.w}; kv[2] = (f2){b.x, b.y}; kv[3] = (f2){b.z, b.w};
      }
      {
        const float4 a = *(const float4*)(L + 256 + j0), b = *(const float4*)(L + 256 + j0 + 4);
        kkv[0] = (f2){a.x, a.y}; kkv[1] = (f2){a.z, a.w}; kkv[2] = (f2){b.x, b.y}; kkv[3] = (f2){b.z, b.w};
      }
      {
        const float4 a = *(const float4*)(L + 320 + j0), b = *(const float4*)(L + 320 + j0 + 4);
        nbv[0] = (f2){a.x, a.y}; nbv[1] = (f2){a.z, a.w}; nbv[2] = (f2){b.x, b.y}; nbv[3] = (f2){b.z, b.w};
      }
      if (OUT) {
        const float4 a = *(const float4*)(L + j0), b = *(const float4*)(L + j0 + 4);
        rv[0] = (f2){a.x, a.y}; rv[1] = (f2){a.z, a.w}; rv[2] = (f2){b.x, b.y}; rv[3] = (f2){b.z, b.w};
      }
      float vi[R];
      if (R == 4) {
        const float4 t = *(const float4*)(L + 192 + ib);
        vi[0] = t.x; vi[1] = t.y; vi[2] = t.z; vi[R - 1] = t.w;
      } else {
        const float2 t = *(const float2*)(L + 192 + ib);
        vi[0] = t.x; vi[1] = t.y;
      }
      float o[R], sum[R];
      f2 t[R];
#pragma unroll
      for (int rr = 0; rr < R; ++rr) t[rr] = S[rr][0] * kkv[0];
#pragma unroll
      for (int rr = 0; rr < R; ++rr) t[rr] = __builtin_elementwise_fma(S[rr][1], kkv[1], t[rr]);
#pragma unroll
      for (int rr = 0; rr < R; ++rr) t[rr] = __builtin_elementwise_fma(S[rr][2], kkv[2], t[rr]);
#pragma unroll
      for (int rr = 0; rr < R; ++rr) t[rr] = __builtin_elementwise_fma(S[rr][3], kkv[3], t[rr]);
#pragma unroll
      for (int rr = 0; rr < R; ++rr) sum[rr] = t[rr].x + t[rr].y;
#pragma unroll
      for (int rr = 0; rr < R; ++rr) sum[rr] += dppf<0x141>(sum[rr]);
#pragma unroll
      for (int rr = 0; rr < R; ++rr) sum[rr] += dppf<0x4E>(sum[rr]);
#pragma unroll
      for (int rr = 0; rr < R; ++rr) sum[rr] += dppf<0xB1>(sum[rr]);
      if (isG) {
#pragma unroll
        for (int q = 0; q < 4; ++q)
#pragma unroll
          for (int rr = 0; rr < R; ++rr) S[rr][q] = __builtin_elementwise_fma(nbv[q], (f2){sum[rr], sum[rr]}, S[rr][q]);
      } else {
#pragma unroll
        for (int q = 0; q < 4; ++q)
#pragma unroll
          for (int rr = 0; rr < R; ++rr)
            S[rr][q] = __builtin_elementwise_fma(kv[q], (f2){vi[rr], vi[rr]}, __builtin_elementwise_fma(nbv[q], (f2){sum[rr], sum[rr]}, S[rr][q]));
      }
      if (OUT) {
#pragma unroll
        for (int rr = 0; rr < R; ++rr) t[rr] = S[rr][0] * rv[0];
#pragma unroll
        for (int rr = 0; rr < R; ++rr) t[rr] = __builtin_elementwise_fma(S[rr][1], rv[1], t[rr]);
#pragma unroll
        for (int rr = 0; rr < R; ++rr) t[rr] = __builtin_elementwise_fma(S[rr][2], rv[2], t[rr]);
#pragma unroll
        for (int rr = 0; rr < R; ++rr) t[rr] = __builtin_elementwise_fma(S[rr][3], rv[3], t[rr]);
#pragma unroll
        for (int rr = 0; rr < R; ++rr) o[rr] = t[rr].x + t[rr].y;
#pragma unroll
        for (int rr = 0; rr < R; ++rr) o[rr] += dppf<0x141>(o[rr]);
#pragma unroll
        for (int rr = 0; rr < R; ++rr) o[rr] += dppf<0x4E>(o[rr]);
#pragma unroll
        for (int rr = 0; rr < R; ++rr) o[rr] += dppf<0xB1>(o[rr]);
      }
      if ((s & 7) == 7 || s == n - 1) {
        const float4 a = *(const float4*)(L + 64 + j0), b = *(const float4*)(L + 64 + j0 + 4);
        const f2 c0 = {a.x, a.y}, c1 = {a.z, a.w}, c2 = {b.x, b.y}, c3 = {b.z, b.w};
#pragma unroll
        for (int rr = 0; rr < R; ++rr) { S[rr][0] *= c0; S[rr][1] *= c1; S[rr][2] *= c2; S[rr][3] *= c3; }
      }
      if (OUT && cg == 0) {
        float* op = buf + 12288 + s * 64 + ib;
        if (R == 4) *(float4*)op = make_float4(o[0], o[1], o[2], o[R - 1]);
        else *(float2*)op = make_float2(o[0], o[1]);
      }
    }
    if (OUT) {
      __syncthreads();
      const int tk = tid >> 4, ch = (tid & 15) * 4;
      if (tk < n) {
        const float4 o4 = *(const float4*)(buf + 12288 + tk * 64 + ch);
        const float mean = row16_sum(o4.x + o4.y + o4.z + o4.w) * (1.f / 64.f);
        const float d0 = o4.x - mean, d1 = o4.y - mean, d2 = o4.z - mean, d3 = o4.w - mean;
        const float rstd = rsqrtf(row16_sum(d0 * d0 + d1 * d1 + d2 * d2 + d3 * d3) * (1.f / 64.f) + 64e-5f);
        const float* L = cb + tk * 384;
        const float4 r4 = *(const float4*)(L + ch), k4 = *(const float4*)(L + 128 + ch), v4 = *(const float4*)(L + 192 + ch);
        const float4 rk4 = *(const float4*)(p.r_k + h * 64 + ch);
        const float4 lg = *(const float4*)(p.lnx_g + h * 64 + ch), lb = *(const float4*)(p.lnx_b + h * 64 + ch);
        const float bsum = row16_sum(r4.x * k4.x * rk4.x + r4.y * k4.y * rk4.y + r4.z * k4.z * rk4.z + r4.w * k4.w * rk4.w);
        const long row = row0 + s0 + tk;
        const float4 gt = *(const float4*)(p.P + row * ECP + 3136 + h * 64 + ch);
        ushort4 ob;
        ob.x = f2bf((d0 * rstd * lg.x + lb.x + bsum * v4.x) * siluf_(gt.x));
        ob.y = f2bf((d1 * rstd * lg.y + lb.y + bsum * v4.y) * siluf_(gt.y));
        ob.z = f2bf((d2 * rstd * lg.z + lb.z + bsum * v4.z) * siluf_(gt.z));
        ob.w = f2bf((d3 * rstd * lg.w + lb.w + bsum * v4.w) * siluf_(gt.w));
        *(ushort4*)(p.Y + row * 1024 + 512 + h * 64 + ch) = ob;
      }
    }
    if (c + 1 < nch) {
      float* nbuf = buf + ((c + 1) & 1) * 6144;
#pragma unroll
      for (int q = 0; q < 6; ++q) *(float4*)(nbuf + (tid + q * 256) * 4) = pre[q];
    }
    __syncthreads();
  }
  float* fin = isG ? fin1 : fin0;
  if (fin) {
#pragma unroll
    for (int rr = 0; rr < R; ++rr) {
      *(float4*)(fin + (ib + rr) * 64 + j0) = make_float4(S[rr][0].x, S[rr][0].y, S[rr][1].x, S[rr][1].y);
      *(float4*)(fin + (ib + rr) * 64 + j0 + 4) = make_float4(S[rr][2].x, S[rr][2].y, S[rr][3].x, S[rr][3].y);
    }
  }
}

__device__ void scan_pass2(const Params& p, int item, char* smem) {
  float* sS = (float*)smem;
  float* red = sS + 512;
  const int tid = threadIdx.x, q = tid >> 6, j = tid & 63;
  const int h = item >> 3, i0 = (item & 7) * 8;
  const int oi = tid >> 5, oj = (tid & 31) * 2;
  float s0 = 0.f, s1 = 0.f;
  float g[16], gn[16];
  const float* Gh = p.Gbuf + (long)h * NCH * 4096;
  const float* Hh = p.Hbuf + (long)h * NCH * 4096;
  float* Sh = p.Sst + (long)h * NCH * 4096;
#pragma unroll
  for (int u = 0; u < 16; ++u) g[u] = Gh[(q * 16 + u) * 64 + j];
  float2 hv = *(const float2*)(Hh + (i0 + oi) * 64 + oj), hn = hv;
  __syncthreads();
  for (int c = 0; c < NCH; ++c) {
    *(float2*)(Sh + (long)c * 4096 + (i0 + oi) * 64 + oj) = make_float2(s0, s1);
    sS[oj * 8 + oi] = s0;
    sS[(oj + 1) * 8 + oi] = s1;
    __syncthreads();
    if (c + 1 < NCH) {
#pragma unroll
      for (int u = 0; u < 16; ++u) gn[u] = Gh[(long)(c + 1) * 4096 + (q * 16 + u) * 64 + j];
      hn = *(const float2*)(Hh + (long)(c + 1) * 4096 + (i0 + oi) * 64 + oj);
    }
    float acc[8];
#pragma unroll
    for (int i = 0; i < 8; ++i) acc[i] = 0.f;
#pragma unroll
    for (int u = 0; u < 16; ++u) {
      const int jp = q * 16 + u;
      const float4 sa = *(const float4*)(sS + jp * 8), sb = *(const float4*)(sS + jp * 8 + 4);
      acc[0] += sa.x * g[u]; acc[1] += sa.y * g[u]; acc[2] += sa.z * g[u]; acc[3] += sa.w * g[u];
      acc[4] += sb.x * g[u]; acc[5] += sb.y * g[u]; acc[6] += sb.z * g[u]; acc[7] += sb.w * g[u];
    }
#pragma unroll
    for (int i = 0; i < 8; ++i) red[(q * 8 + i) * 64 + j] = acc[i];
    __syncthreads();
    s0 = hv.x; s1 = hv.y;
    hv = hn;
#pragma unroll
    for (int qq = 0; qq < 4; ++qq) {
      const float2 rv = *(const float2*)(red + (qq * 8 + oi) * 64 + oj);
      s0 += rv.x; s1 += rv.y;
    }
#pragma unroll
    for (int u = 0; u < 16; ++u) g[u] = gn[u];
  }
  *(float2*)(p.wkv_p + h * 4096 + (i0 + oi) * 64 + oj) = make_float2(s0, s1);
}

DEVI void conv1(const Params& p, int row0, int ch, float (&a)[4]) {
  const bool prm = row0 < T;
  const int bb = (row0 - T) >> 2;
  const float* pb = p.U + (long)(row0 - 30) * 512 + ch;
  const float* pa = prm ? pb : p.state_conv + (long)(bb * 30) * 512 + ch;
  float u[34];
#pragma unroll
  for (int e = 0; e < 34; ++e) u[e] = (e < 30 ? pa : pb)[e * 512];
  const float cb0 = p.conv_b[ch];
#pragma unroll
  for (int r = 0; r < 4; ++r) a[r] = cb0;
#pragma unroll
  for (int j = 0; j < 31; ++j) {
    const float w0 = p.conv_w[j * 512 + ch];
#pragma unroll
    for (int r = 0; r < 4; ++r) a[r] += w0 * u[j + r];
  }
}
__device__ void conv_wave_item(const Params& p, int grp, float* cbuf  ) {
  const int lane = threadIdx.x & 63;
  const int row0 = grp * 4;
  float s0 = 0.f, s1 = 0.f, s2 = 0.f, s3 = 0.f;
#pragma unroll 1
  for (int c = 0; c < 8; ++c) {
    float a[4];
    conv1(p, row0, c * 64 + lane, a);
    s0 += a[0]; s1 += a[1]; s2 += a[2]; s3 += a[3];
    cbuf[(c * 4 + 0) * 64 + lane] = a[0]; cbuf[(c * 4 + 1) * 64 + lane] = a[1];
    cbuf[(c * 4 + 2) * 64 + lane] = a[2]; cbuf[(c * 4 + 3) * 64 + lane] = a[3];
  }
  const float m0 = wave_sum(s0) * (1.f / 512.f), m1 = wave_sum(s1) * (1.f / 512.f), m2 = wave_sum(s2) * (1.f / 512.f),
              m3 = wave_sum(s3) * (1.f / 512.f);
  float q0 = 0.f, q1 = 0.f, q2 = 0.f, q3 = 0.f;
#pragma unroll
  for (int c = 0; c < 8; ++c) {
    const float d0 = cbuf[(c * 4 + 0) * 64 + lane] - m0, d1 = cbuf[(c * 4 + 1) * 64 + lane] - m1,
                d2 = cbuf[(c * 4 + 2) * 64 + lane] - m2, d3 = cbuf[(c * 4 + 3) * 64 + lane] - m3;
    q0 += d0 * d0; q1 += d1 * d1; q2 += d2 * d2; q3 += d3 * d3;
  }
  const float r0 = rsqrtf(wave_sum(q0) * (1.f / 512.f) + 1e-5f), r1 = rsqrtf(wave_sum(q1) * (1.f / 512.f) + 1e-5f),
              r2 = rsqrtf(wave_sum(q2) * (1.f / 512.f) + 1e-5f), r3 = rsqrtf(wave_sum(q3) * (1.f / 512.f) + 1e-5f);
#pragma unroll 2
  for (int c = 0; c < 8; ++c) {
    const int ch = c * 64 + lane;
    const float lg = p.cln_g[ch], lb = p.cln_b[ch];
    const float y0 = (cbuf[(c * 4 + 0) * 64 + lane] - m0) * r0 * lg + lb, y1 = (cbuf[(c * 4 + 1) * 64 + lane] - m1) * r1 * lg + lb,
                y2 = (cbuf[(c * 4 + 2) * 64 + lane] - m2) * r2 * lg + lb, y3 = (cbuf[(c * 4 + 3) * 64 + lane] - m3) * r3 * lg + lb;
    const float g0 = p.P[(long)(row0 + 0) * ECP + 2624 + ch], g1 = p.P[(long)(row0 + 1) * ECP + 2624 + ch],
                g2 = p.P[(long)(row0 + 2) * ECP + 2624 + ch], g3 = p.P[(long)(row0 + 3) * ECP + 2624 + ch];
    p.Y[(long)(row0 + 0) * 1024 + ch] = f2bf(siluf_(y0) * siluf_(g0));
    p.Y[(long)(row0 + 1) * 1024 + ch] = f2bf(siluf_(y1) * siluf_(g1));
    p.Y[(long)(row0 + 2) * 1024 + ch] = f2bf(siluf_(y2) * siluf_(g2));
    p.Y[(long)(row0 + 3) * 1024 + ch] = f2bf(siluf_(y3) * siluf_(g3));
  }
}

__device__ void phaseD1(const Params& p, int bid, int nb, char* smem) {
  for (int it = bid; it < 8 * NCH; it += nb) {
    const int h = it / NCH, c = it - h * NCH;
    scan_chunk<4, true>(p, h, c * CH, CH, nullptr, p.Hbuf + (long)it * 4096, p.Gbuf + (long)it * 4096, smem);
  }
  for (int it = bid; it < 256; it += nb) {
    const int b = it >> 3, h = it & 7;
    scan_chunk<2, false>(p, h, T + b * 4, 4, p.state_wkv + (long)it * 4096, p.wkv_s + (long)it * 4096, nullptr, smem);
  }
  __syncthreads();
  for (int g = bid * 4 + (threadIdx.x >> 6); g < MT / 4; g += nb * 4) conv_wave_item(p, g, (float*)smem + (threadIdx.x >> 6) * 2048);
}
__device__ void phaseD2(const Params& p, int bid, int nb, char* smem) {
  if (bid < 64) { scan_pass2(p, bid, smem); return; }
  copy_cache<128>(p.cache0, p.kvs0, bid - 64, nb - 64);
  copy_cache<512>(p.cache1, p.kvs1, bid - 64, nb - 64);
  copy_cache<2048>(p.cache2, p.kvs2, bid - 64, nb - 64);
}
__device__ void phaseD3(const Params& p, int bid, int nb, char* smem) {
  for (int it = bid; it < 8 * NCH; it += nb) {
    const int h = it / NCH, c = it - h * NCH;
    scan_chunk<2, false>(p, h, c * CH, CH, p.Sst + (long)it * 4096, nullptr, nullptr, smem);
  }
}

__device__ void conv_state_out(const Params& p, int bid, int nb) {
  for (int i = bid * 256 + threadIdx.x; i < 15360 + 491520; i += nb * 256) {
    if (i < 15360) p.conv_p[i] = p.U[(long)(T - 30) * 512 + i];
    else {
      int q = i - 15360, b = q / 15360, rem = q - b * 15360, r = rem >> 9, ch = rem & 511;
      p.conv_s[q] = r < 26 ? p.state_conv[(long)(b * 30 + r + 4) * 512 + ch] : p.U[(long)(T + b * 4 + r - 26) * 512 + ch];
    }
  }
}

__device__ void ln_phase(const float* __restrict__ Z, const float* res0, const float* res1,
                         const float* __restrict__ g, const float* __restrict__ bta,
                         float* out0, float* out1, u16* outb, int bid, int nb) {
  const int lane = threadIdx.x & 63, w = threadIdx.x >> 6;
#pragma unroll 2
  for (int row = bid * 4 + w; row < MT; row += nb * 4) {
    const float4* z4 = (const float4*)(Z + (long)row * 1024);
    float4 v[4];
    float s = 0.f;
    const float4* r4 =(const float4*)(row < T ? res0 + (long)row * 1024 : res1 + (long)(row - T) * 1024);
#pragma unroll
    for (int i = 0; i < 4; ++i) {
      float4 z = z4[lane + i * 64], r = r4[lane + i * 64];
      v[i].x = z.x + ALPHA * r.x; v[i].y = z.y + ALPHA * r.y; v[i].z = z.z + ALPHA * r.z; v[i].w = z.w + ALPHA * r.w;
      s += v[i].x + v[i].y + v[i].z + v[i].w;
    }
    float mean = wave_sum(s) * (1.f / 1024.f);
    float q = 0.f;
#pragma unroll
    for (int i = 0; i < 4; ++i) {
      float a = v[i].x - mean, b = v[i].y - mean, c = v[i].z - mean, d = v[i].w - mean;
      q += a * a + b * b + c * c + d * d;
    }
    float rstd = rsqrtf(wave_sum(q) * (1.f / 1024.f) + 1e-5f);
    float* op = row < T ? out0 + (long)row * 1024 : out1 + (long)(row - T) * 1024;
#pragma unroll
    for (int i = 0; i < 4; ++i) {
      float4 gg = ((const float4*)g)[lane + i * 64], bb = ((const float4*)bta)[lane + i * 64];
      float4 o;
      o.x = (v[i].x - mean) * rstd * gg.x + bb.x;
      o.y = (v[i].y - mean) * rstd * gg.y + bb.y;
      o.z = (v[i].z - mean) * rstd * gg.z + bb.z;
      o.w = (v[i].w - mean) * rstd * gg.w + bb.w;
      ((float4*)op)[lane + i * 64] = o;
      if (outb) {
        ushort4 ob;
        ob.x = f2bf(o.x); ob.y = f2bf(o.y); ob.z = f2bf(o.z); ob.w = f2bf(o.w);
        ((ushort4*)(outb + (long)row * 1024))[lane + i * 64] = ob;
      }
    }
  }
}

DEVI float bf2f(u16 v) { return __uint_as_float((unsigned)v << 16); }
struct AttnItem { int g, dil, h, c, l0, qoff; long rbase; };
DEVI AttnItem attn_decode(int item) {
  AttnItem a;
  a.g = item >> 11;
  const int rem = item & 2047;
  a.dil = a.g == 0 ? 1 : (a.g == 1 ? 4 : 16);
  const int nlb = (T / a.dil) >> 6;
  a.h = rem & 7;
  const int cl = rem >> 3;
  a.c = cl / nlb;
  a.l0 = (cl - a.c * nlb) * 64;
  a.qoff = a.g * 512 + a.h * 64;
  a.rbase = (long)a.c * (T / a.dil);
  return a;
}
DEVI void attn_load_qk(const Params& p, const AttnItem& a, uint4& rq0, uint4& rq1, uint4 (&rk)[6]) {
  const int tid = threadIdx.x;
  const u16* __restrict__ Q = p.QKVG;
  {
    const int row = tid >> 3, cc = tid & 7;
    rq0 = *(const uint4*)(Q + ((long)a.g * MP + a.rbase + a.l0 + row) * 512 + a.h * 64 + cc * 8);
    rq1 = *(const uint4*)(Q + ((long)a.g * MP + a.rbase + a.l0 + row + 32) * 512 + a.h * 64 + cc * 8);
  }
#pragma unroll
  for (int i = 0; i < 6; ++i) {
    const int ch = tid + i * 256, row = ch >> 3, cc = ch & 7;
    const int lp = a.l0 - 128 + row;
    rk[i] = make_uint4(0u, 0u, 0u, 0u);
    if (lp >= 0) rk[i] = *(const uint4*)(Q + ((long)(3 + a.g) * MP + a.rbase + lp) * 512 + a.h * 64 + cc * 8);
  }
}
DEVI void attn_load_v(const Params& p, const AttnItem& a, uint4 (&rv)[8]) {
  const int tid = threadIdx.x;
  const u16* __restrict__ Q = p.QKVG;
#pragma unroll
  for (int i = 0; i < 2; ++i) {
    const int task = tid + i * 256, kq = task >> 3, dq = task & 7;
#pragma unroll
    for (int u = 0; u < 4; ++u) {
      const int ki = kq * 4 + u, lp = a.l0 - 128 + ki;
      rv[i * 4 + u] = make_uint4(0u, 0u, 0u, 0u);
      if (task < 416 && ki < 192 && lp >= 0)
        rv[i * 4 + u] = *(const uint4*)(Q + ((long)(6 + a.g) * MP + a.rbase + lp) * 512 + a.h * 64 + dq * 8);
    }
  }
}
DEVI unsigned pk_lo(unsigned a, unsigned b) { return (a & 0xffffu) | (b << 16); }
DEVI unsigned pk_hi(unsigned a, unsigned b) { return (a >> 16) | (b & 0xffff0000u); }
DEVI void attn_store_v(u16* sVt, const uint4 (&rv)[8]) {
  const int tid = threadIdx.x;
#pragma unroll
  for (int i = 0; i < 2; ++i) {
    const int task = tid + i * 256, kq = task >> 3, dq = task & 7;
    if (task < 416) {
      const uint4 v0 = rv[i * 4], v1 = rv[i * 4 + 1], v2 = rv[i * 4 + 2], v3 = rv[i * 4 + 3];
      u16* base = sVt + (dq * 8) * 208 + kq * 4;
      *(uint2*)(base + 0 * 208) = make_uint2(pk_lo(v0.x, v1.x), pk_lo(v2.x, v3.x));
      *(uint2*)(base + 1 * 208) = make_uint2(pk_hi(v0.x, v1.x), pk_hi(v2.x, v3.x));
      *(uint2*)(base + 2 * 208) = make_uint2(pk_lo(v0.y, v1.y), pk_lo(v2.y, v3.y));
      *(uint2*)(base + 3 * 208) = make_uint2(pk_hi(v0.y, v1.y), pk_hi(v2.y, v3.y));
      *(uint2*)(base + 4 * 208) = make_uint2(pk_lo(v0.z, v1.z), pk_lo(v2.z, v3.z));
      *(uint2*)(base + 5 * 208) = make_uint2(pk_hi(v0.z, v1.z), pk_hi(v2.z, v3.z));
      *(uint2*)(base + 6 * 208) = make_uint2(pk_lo(v0.w, v1.w), pk_lo(v2.w, v3.w));
      *(uint2*)(base + 7 * 208) = make_uint2(pk_hi(v0.w, v1.w), pk_hi(v2.w, v3.w));
    }
  }
}

__device__ void attn_prompt_phase(const Params& p, int bid, int nb, char* smem) {
  u16* sQ = (u16*)smem;
  u16* sK = sQ + 64 * 72;
  u16* sVt = sK;
  u16* sP = sK + 192 * 72;
  const int tid = threadIdx.x, lane = tid & 63, w = tid >> 6, lr = lane & 15, lq = lane >> 4;
  uint4 rq0, rq1, rk[6], rv[8];
  { AttnItem a = attn_decode(min(bid, 6143)); attn_load_qk(p, a, rq0, rq1, rk); }
  for (int item = bid; item < 6144; item += nb) {
    const AttnItem a = attn_decode(item);
    __syncthreads();
    *(uint4*)&sQ[(tid >> 3) * 72 + (tid & 7) * 8] = rq0;
    *(uint4*)&sQ[((tid >> 3) + 32) * 72 + (tid & 7) * 8] = rq1;
#pragma unroll
    for (int i = 0; i < 6; ++i) { const int ch = tid + i * 256; *(uint4*)&sK[(ch >> 3) * 72 + (ch & 7) * 8] = rk[i]; }
    __syncthreads();
    attn_load_v(p, a, rv);
    bf16x8 qf[2];
    qf[0] = *(const bf16x8*)&sQ[(w * 16 + lr) * 72 + lq * 8];
    qf[1] = *(const bf16x8*)&sQ[(w * 16 + lr) * 72 + 32 + lq * 8];
    f32x4 s[9];
#pragma unroll
    for (int kt = 0; kt < 9; ++kt) {
      s[kt] = (f32x4){0.f, 0.f, 0.f, 0.f};
#pragma unroll
      for (int ks = 0; ks < 2; ++ks) {
        bf16x8 kf = *(const bf16x8*)&sK[((w + kt) * 16 + lr) * 72 + ks * 32 + lq * 8];
        s[kt] = __builtin_amdgcn_mfma_f32_16x16x32_bf16(qf[ks], kf, s[kt], 0, 0, 0);
      }
    }
    float m[4], sum[4];
#pragma unroll
    for (int j = 0; j < 4; ++j) m[j] = -1e30f;
#pragma unroll
    for (int kt = 0; kt < 9; ++kt) {
      const int lp = a.l0 - 128 + (w + kt) * 16 + lr;
#pragma unroll
      for (int j = 0; j < 4; ++j) {
        const int delta = lq * 4 + j + 128 - kt * 16 - lr;
        const bool valid = (delta >= 0) && (delta <= 128) && (lp >= 0);
        const float v = valid ? s[kt][j] : -1e30f;
        s[kt][j] = v;
        m[j] = fmaxf(m[j], v);
      }
    }
#pragma unroll
    for (int j = 0; j < 4; ++j) m[j] = fmaxf(m[j], dppf<0x128>(m[j]));
#pragma unroll
    for (int j = 0; j < 4; ++j) m[j] = fmaxf(m[j], dppf<0x124>(m[j]));
#pragma unroll
    for (int j = 0; j < 4; ++j) m[j] = fmaxf(m[j], dppf<0x4E>(m[j]));
#pragma unroll
    for (int j = 0; j < 4; ++j) m[j] = fmaxf(m[j], dppf<0xB1>(m[j]));
#pragma unroll
    for (int j = 0; j < 4; ++j) sum[j] = 0.f;
#pragma unroll
    for (int kt = 0; kt < 9; ++kt) {
#pragma unroll
      for (int j = 0; j < 4; ++j) {
        const float pe = s[kt][j] > -1e29f ? __expf(s[kt][j] - m[j]) : 0.f;
        s[kt][j] = pe;
        sum[j] += pe;
      }
    }
#pragma unroll
    for (int j = 0; j < 4; ++j) sum[j] += dppf<0x128>(sum[j]);
#pragma unroll
    for (int j = 0; j < 4; ++j) sum[j] += dppf<0x124>(sum[j]);
#pragma unroll
    for (int j = 0; j < 4; ++j) sum[j] += dppf<0x4E>(sum[j]);
#pragma unroll
    for (int j = 0; j < 4; ++j) sum[j] += dppf<0xB1>(sum[j]);
    u16* wp = sP + w * 16 * 168;
#pragma unroll
    for (int j = 0; j < 4; ++j) {
#pragma unroll
      for (int kt = 0; kt < 9; ++kt) wp[(lq * 4 + j) * 168 + kt * 16 + lr] = f2bf(s[kt][j]);
      wp[(lq * 4 + j) * 168 + 144 + lr] = 0;
    }
    __syncthreads();
    attn_store_v(sVt, rv);
    { AttnItem an = attn_decode(min(item + nb, 6143)); attn_load_qk(p, an, rq0, rq1, rk); }
    __syncthreads();
    f32x4 o[4];
#pragma unroll
    for (int nt = 0; nt < 4; ++nt) o[nt] = (f32x4){0.f, 0.f, 0.f, 0.f};
#pragma unroll
    for (int ks = 0; ks < 5; ++ks) {
      bf16x8 pf = *(const bf16x8*)&wp[lr * 168 + ks * 32 + lq * 8];
#pragma unroll
      for (int nt = 0; nt < 4; ++nt) {
        bf16x8 vf = *(const bf16x8*)&sVt[(nt * 16 + lr) * 208 + w * 16 + ks * 32 + lq * 8];
        o[nt] = __builtin_amdgcn_mfma_f32_16x16x32_bf16(pf, vf, o[nt], 0, 0, 0);
      }
    }
#pragma unroll
    for (int j = 0; j < 4; ++j) {
      long t = (long)(a.l0 + w * 16 + lq * 4 + j) * a.dil + a.c;
      float inv = 1.f / sum[j];
#pragma unroll
      for (int nt = 0; nt < 4; ++nt) p.AO[((long)a.g * MT + t) * 512 + a.h * 64 + nt * 16 + lr] = o[nt][j] * inv;
      if (lr == 0) p.LSE[((long)a.g * MT + t) * 8 + a.h] = m[j] + __logf(sum[j]);
    }
  }
}

DEVI float4 us4_to_f4(ushort4 v) { return make_float4(bf2f(v.x), bf2f(v.y), bf2f(v.z), bf2f(v.w)); }
__device__ void attn_sample_item(const Params& p, int witem, float* sp) {
  const int lane = threadIdx.x & 63, l16 = lane & 15, kq = lane >> 4;
  const int h = witem & 7, g = (witem >> 3) % 3, bs = witem / 24, b = bs >> 2, s = bs & 3;
  const int dil = g == 0 ? 1 : (g == 1 ? 4 : 16);
  const int W = g == 0 ? 128 : (g == 1 ? 512 : 2048);
  const float* cache = g == 0 ? p.cache0 : (g == 1 ? p.cache1 : p.cache2);
  const int row = T + b * 4 + s;
  const float4 q4 = us4_to_f4(*(const ushort4*)(p.QKVG + qs_off(g, row) + h * 64 + l16 * 4));
  const int jstart = g == 0 ? s + 1 : 1;
  for (int j = 0; j < jstart; ++j) {
    const float4 k4 = us4_to_f4(*(const ushort4*)(p.QKVG + qs_off(3 + g, row - dil * j) + h * 64 + l16 * 4));
    const float sc = row16_sum(k4.x * q4.x + k4.y * q4.y + k4.z * q4.z + k4.w * q4.w);
    if (lane == 0) sp[j] = sc;
  }
  const float* cbase = cache + (long)b * W * 1024 + h * 64 + l16 * 4;
#pragma unroll 11
  for (int jj = 0; jj < 33; ++jj) {
    const int j = jstart + jj * 4 + kq, jc = min(j, 128), idx = W + s - dil * jc;
    const float4 k4 = *(const float4*)(cbase + (long)idx * 1024);
    const float sc = row16_sum(k4.x * q4.x + k4.y * q4.y + k4.z * q4.z + k4.w * q4.w);
    if (l16 == 0 && j <= 128) sp[j] = sc;
  }
  __builtin_amdgcn_s_waitcnt(0);
  __builtin_amdgcn_wave_barrier();
  const float a0 = sp[lane], a1 = sp[lane + 64], a2 = lane == 0 ? sp[128] : -1e30f;
  const float mx = wave_max(fmaxf(fmaxf(a0, a1), a2));
  const float e0 = __expf(a0 - mx), e1 = __expf(a1 - mx), e2 = lane == 0 ? __expf(a2 - mx) : 0.f;
  const float sm = wave_sum(e0 + e1 + e2);
  __builtin_amdgcn_wave_barrier();
  sp[lane] = e0; sp[lane + 64] = e1;
  if (lane == 0) sp[128] = e2;
  __builtin_amdgcn_s_waitcnt(0);
  __builtin_amdgcn_wave_barrier();
  float4 acc = make_float4(0.f, 0.f, 0.f, 0.f);
  for (int j = 0; j < jstart; ++j) {
    const float4 v4 = us4_to_f4(*(const ushort4*)(p.QKVG + qs_off(6 + g, row - dil * j) + h * 64 + l16 * 4));
    const float pj = kq == 0 ? sp[j] : 0.f;
    acc.x += pj * v4.x; acc.y += pj * v4.y; acc.z += pj * v4.z; acc.w += pj * v4.w;
  }
#pragma unroll 11
  for (int jj = 0; jj < 33; ++jj) {
    const int j = jstart + jj * 4 + kq, jc = min(j, 128), idx = W + s - dil * jc;
    const float4 v4 = *(const float4*)(cbase + (long)idx * 1024 + 512);
    const float pj = j <= 128 ? sp[jc] : 0.f;
    acc.x += pj * v4.x; acc.y += pj * v4.y; acc.z += pj * v4.z; acc.w += pj * v4.w;
  }
  acc.x += __shfl_xor(acc.x, 16); acc.y += __shfl_xor(acc.y, 16); acc.z += __shfl_xor(acc.z, 16); acc.w += __shfl_xor(acc.w, 16);
  acc.x += __shfl_xor(acc.x, 32); acc.y += __shfl_xor(acc.y, 32); acc.z += __shfl_xor(acc.z, 32); acc.w += __shfl_xor(acc.w, 32);
  const float inv = 1.f / sm;
  if (kq == 0)
    *(float4*)(p.AO + ((long)g * MT + row) * 512 + h * 64 + l16 * 4) = make_float4(acc.x * inv, acc.y * inv, acc.z * inv, acc.w * inv);
  if (lane == 0) p.LSE[((long)g * MT + row) * 8 + h] = mx + __logf(sm);
  __builtin_amdgcn_wave_barrier();
}

__device__ void phaseI(const Params& p, int bid, int nb, char* smem) {
  attn_prompt_phase(p, bid, nb, smem);
  __syncthreads();
  float* sp = (float*)smem + (threadIdx.x >> 6) * 160;
  for (int it = bid * 4 + (threadIdx.x >> 6); it < 3072; it += nb * 4) attn_sample_item(p, it, sp);
}

DEVI float4 bf4_to_f4(uint2 v) {
  return make_float4(__uint_as_float(v.x << 16), __uint_as_float(v.x & 0xffff0000u), __uint_as_float(v.y << 16),
                     __uint_as_float(v.y & 0xffff0000u));
}
__device__ void copy_kv_out(const Params& p, int g, int W, float* kvp, float* kvs, int bid, int nb) {
  const u16* Q = p.QKVG;
  const int np = W * 256;
  const int ns = 32 * 4 * 256;
#pragma unroll 4
  for (int i = bid * 256 + threadIdx.x; i < np + ns; i += nb * 256) {
    if (i < np) {
      int r = i >> 8, rem = i & 255, kv = rem >> 7, c4 = rem & 127;
      ((float4*)kvp)[i] = bf4_to_f4(*(const uint2*)(Q + qs_off(3 + kv * 3 + g, qs_perm(T - W + r, g)) + c4 * 4));
    } else {
      int q = i - np, bs = q >> 8, rem = q & 255, kv = rem >> 7, c4 = rem & 127, b = bs >> 2, s = bs & 3;
      ((float4*)kvs)[((long)(b * W + W - 4 + s) * 2 + kv) * 128 + c4] =
          bf4_to_f4(*(const uint2*)(Q + qs_off(3 + kv * 3 + g, T + bs) + c4 * 4));
    }
  }
}

__device__ void phaseI2(const Params& p, int bid, int nb) {
  const int tid = threadIdx.x;
#pragma unroll 4
  for (int i = bid * 256 + tid; i < MT * 128; i += nb * 256) {
    int row = i >> 7, c4 = i & 127, h = c4 >> 4;
    float l0 = p.LSE[((long)row) * 8 + h], l1 = p.LSE[((long)MT + row) * 8 + h], l2 = p.LSE[((long)2 * MT + row) * 8 + h];
    float mx = fmaxf(l0, fmaxf(l1, l2));
    float e0 = __expf(l0 - mx), e1 = __expf(l1 - mx), e2 = __expf(l2 - mx);
    float inv = 1.f / (e0 + e1 + e2);
    e0 *= inv; e1 *= inv; e2 *= inv;
    float4 a0 = ((const float4*)p.AO)[(long)row * 128 + c4];
    float4 a1 = ((const float4*)p.AO)[((long)MT + row) * 128 + c4];
    float4 a2 = ((const float4*)p.AO)[((long)2 * MT + row) * 128 + c4];
    float4 gt = bf4_to_f4(*(const uint2*)(p.QKVG + qs_off(9, row) + c4 * 4));
    ushort4 ob;
    ob.x = f2bf((e0 * a0.x + e1 * a1.x + e2 * a2.x) * siluf_(gt.x));
    ob.y = f2bf((e0 * a0.y + e1 * a1.y + e2 * a2.y) * siluf_(gt.y));
    ob.z = f2bf((e0 * a0.z + e1 * a1.z + e2 * a2.z) * siluf_(gt.z));
    ob.w = f2bf((e0 * a0.w + e1 * a1.w + e2 * a2.w) * siluf_(gt.w));
    ((ushort4*)p.O2)[(long)row * 128 + c4] = ob;
  }
  copy_kv_out(p, 0, 128, p.kvp0, p.kvs0, bid, nb);
  copy_kv_out(p, 1, 512, p.kvp1, p.kvs1, bid, nb);
  copy_kv_out(p, 2, 2048, p.kvp2, p.kvs2, bid, nb);
}

#define XB_TMO      128
#define XB_XCNT(j)  (256  + 64 * (j))
#define XB_XSUB(j)  (1280 + 64 * (j))
#define XB_XGEN(j)  (2304 + 64 * (j))
#define XB_TOP      3328
#define XB_TOPGEN   3392
#define XCD_BAR_WORDS 3456
#define XB_SPIN_CAP (1u << 18)
#define LAS __attribute__((address_space(3)))

__device__ __forceinline__ unsigned xb_ld(unsigned* p)              { return __hip_atomic_load(p, __ATOMIC_RELAXED, __HIP_MEMORY_SCOPE_AGENT); }
__device__ __forceinline__ unsigned xb_add(unsigned* p, unsigned v) { return __hip_atomic_fetch_add(p, v, __ATOMIC_RELAXED, __HIP_MEMORY_SCOPE_AGENT); }
__device__ __forceinline__ unsigned xb_xcc_id() { return (unsigned)__builtin_amdgcn_s_getreg((3 << 11) | 20) & 0xFu; }
#define XB_SPIN(cond, bar) do { unsigned _sp = 0; while (cond) { __builtin_amdgcn_s_sleep(1); \
    if ((++_sp & 255u) == 0u) { if (xb_ld(&(bar)[XB_TMO])) break; if (_sp > XB_SPIN_CAP) { atomicAdd(&(bar)[XB_TMO], 1u); break; } } } } while (0)

struct XcdBarrier {
    unsigned* bar; unsigned x;
    volatile LAS unsigned* st;
};

__device__ __forceinline__ XcdBarrier xcd_barrier_post(unsigned* bar, volatile LAS unsigned* st) {
    XcdBarrier b; b.bar = bar; b.x = xb_xcc_id(); b.st = st;
    if (threadIdx.x == 0) (void)xb_add(&bar[XB_XCNT(b.x)], 1u);
    return b;
}
__device__ __forceinline__ void xcd_barrier_complete(unsigned* bar, unsigned x, unsigned& nloc, unsigned& nx) {
    const unsigned G = gridDim.x * gridDim.y * gridDim.z;
    unsigned sum, cnt, mine, sp = 0u;
    for (;;) {
        sum = 0u; cnt = 0u; mine = 0u;
#pragma unroll
        for (unsigned j = 0; j < 16; ++j) { const unsigned c = xb_ld(&bar[XB_XCNT(j)]); sum += c; cnt += (c > 0u) ? 1u : 0u; mine = (j == x) ? c : mine; }
        if (sum == G) break;
        __builtin_amdgcn_s_sleep(1);
        if ((++sp & 255u) == 0u) { if (xb_ld(&bar[XB_TMO])) break; if (sp > XB_SPIN_CAP) { atomicAdd(&bar[XB_TMO], 1u); break; } }
    }
    nloc = mine > 0u ? mine : 1u; nx = cnt > 0u ? cnt : 1u;
}

__device__ __forceinline__ void xcd_barrier(const XcdBarrier& b) {
    asm volatile("s_waitcnt vmcnt(0)" ::: "memory");
    __syncthreads();
    if (threadIdx.x == 0) {
        unsigned* bar = b.bar;
        __builtin_amdgcn_s_waitcnt(0);
        unsigned nloc = b.st[0], nx = b.st[1];
        if (nloc == 0u) { xcd_barrier_complete(bar, b.x, nloc, nx); b.st[0] = nloc; b.st[1] = nx; }
        const unsigned old = xb_add(&bar[XB_XSUB(b.x)], 1u);
        const unsigned gen = old / nloc;
        if (old + 1u == (gen + 1u) * nloc) {
            __builtin_amdgcn_fence(__ATOMIC_RELEASE, "agent");
            asm volatile("s_waitcnt vmcnt(0)" ::: "memory");
            const unsigned og = xb_add(&bar[XB_TOP], 1u);
            const unsigned tg = og / nx;
            if (og + 1u == (tg + 1u) * nx) xb_add(&bar[XB_TOPGEN], 1u);
            else XB_SPIN(xb_ld(&bar[XB_TOPGEN]) == tg, bar);
            __builtin_amdgcn_fence(__ATOMIC_ACQUIRE, "agent");
            xb_add(&bar[XB_XGEN(b.x)], 1u);
            asm volatile("s_waitcnt vmcnt(0)" ::: "memory");
        } else {
            XB_SPIN(xb_ld(&bar[XB_XGEN(b.x)]) == gen, bar);
            __builtin_amdgcn_fence(__ATOMIC_ACQUIRE, "agent");
            asm volatile("s_waitcnt vmcnt(0)" ::: "memory");
        }
    }
    __syncthreads();
}


template <int PH> DEVI void run_phase(const Params& p, int bid, int nb, char* smem) {
  if (PH == 0) phaseA(p, bid, nb, smem);
  if (PH == 1) gemm_big<0>(p.Xb, p.WinE, 1024, 65, 29, p.P, ECP, bid, nb, smem);
  if (PH == 2) phaseC(p, bid, nb, smem);
  if (PH == 3) phaseD1(p, bid, nb, smem);
  if (PH == 4) phaseD2(p, bid, nb, smem);
  if (PH == 5) { phaseD3(p, bid, nb, smem); conv_state_out(p, bid, nb); }
  if (PH == 6) gemm_phase<0>(p.Y, p.WoutE, 1024, 129, 8, p.Z, 1024, nullptr, nullptr, bid, nb, smem);
  if (PH == 7) ln_phase(p.Z, p.x_prompt, p.x_sample, p.ln_g, p.ln_b, p.X1, p.X1 + (long)T * 1024, p.X1b, bid, nb);
  if (PH == 8) gemm_big<2>(p.X1b, p.WinO, 1024, 65, 40, (float*)p.QKVG, OC, bid, nb, smem);
  if (PH == 9) phaseI(p, bid, nb, smem);
  if (PH == 10) phaseI2(p, bid, nb);
  if (PH == 11) gemm_phase<0>(p.O2, p.WoutO, 512, 129, 8, p.Z, 1024, nullptr, nullptr, bid, nb, smem);
  if (PH == 12) ln_phase(p.Z, p.X1, p.X1 + (long)T * 1024, p.ln_g + 1024, p.ln_b + 1024, p.y_prompt, p.y_sample, nullptr, bid, nb);
}
constexpr int NPH = 13;
template <int PH> DEVI void run_all(const Params& p, int bid, int nb, char* smem, const XcdBarrier& xb) {
  run_phase<PH>(p, bid, nb, smem);
  if constexpr (((REPMASK) >> PH) & 1) { xcd_barrier(xb); run_phase<PH>(p, bid, nb, smem); }
  if constexpr (PH + 1 < NPH) { xcd_barrier(xb); run_all<PH + 1>(p, bid, nb, smem, xb); }
}

#if MEGA
__global__ void __launch_bounds__(256, 2) mega_kernel(Params p) {
  __shared__ __attribute__((aligned(16))) char smem[SMEM_BYTES];
  __shared__ uint4 xb_words;
  const int bid = blockIdx.x, nb = gridDim.x;
  if (threadIdx.x == 0) xb_words = make_uint4(0u, 0u, 0u, 0u);
  __syncthreads();
  XcdBarrier xb = xcd_barrier_post(p.bar, (volatile LAS unsigned*)&xb_words);
  if (p.bar == nullptr) cg::this_grid().sync();
#ifdef XSYNC
  for (int i = 0; i < XSYNC; ++i) xcd_barrier(xb);
#endif
  run_all<0>(p, bid, nb, smem, xb);
}
#else
template <int PH> __global__ void __launch_bounds__(256, 2) phase_kernel(Params p) {
  __shared__ __attribute__((aligned(16))) char smem[SMEM_BYTES];
  run_phase<PH>(p, blockIdx.x, gridDim.x, smem);
}
#endif

extern "C" void kernel_launch(void* const* d_in, const int* in_sizes, int n_in, void* d_out, int out_size,
                              void* d_ws, size_t ws_size, hipStream_t stream) {
  Params p{};
  const float** ins = (const float**)&p.x_prompt;
  for (int i = 0; i < 28; ++i) ins[i] = (const float*)d_in[i];
  float* o = (float*)d_out;
  p.y_prompt = o; o += 16777216;
  p.y_sample = o; o += 131072;
  p.conv_p = o; o += 15360;
  p.conv_s = o; o += 491520;
  p.shift_p = o; o += 1024;
  p.shift_s = o; o += 32768;
  p.wkv_p = o; o += 32768;
  p.wkv_s = o; o += 1048576;
  p.kvp0 = o; o += 131072;
  p.kvs0 = o; o += 4194304;
  p.kvp1 = o; o += 524288;
  p.kvs1 = o; o += 16777216;
  p.kvp2 = o; o += 2097152;
  p.kvs2 = o; o += 67108864;
  char* w = (char*)d_ws;
  size_t off = 0;
  auto take = [&](size_t bytes) { char* r = w + off; off += (bytes + 255) & ~(size_t)255; return r; };
  p.Xb = (u16*)take((size_t)MP * 1024 * 2);
  p.WinE = (u16*)take((size_t)ECP * 1024 * 2);
  p.WoutE = (u16*)take((size_t)1024 * 1024 * 2);
  p.WinO = (u16*)take((size_t)OC * 1024 * 2);
  p.WoutO = (u16*)take((size_t)1024 * 512 * 2);
  p.Y = (u16*)take((size_t)MP * 1024 * 2);
  p.X1b = (u16*)take((size_t)MP * 1024 * 2);
  p.O2 = (u16*)take((size_t)MP * 512 * 2);
  p.Z = (float*)take((size_t)MP * 1024 * 4);
  p.X1 = (float*)take((size_t)MP * 1024 * 4);
  size_t offB = off;
  p.P = (float*)take((size_t)MP * ECP * 4);
  p.scan = (float*)take((size_t)6 * SCAN_STRIDE * 4);
  p.U = (float*)take((size_t)(SCAN_STRIDE + 30 * 512) * 4) + 30 * 512;
  p.Oraw = (float*)take((size_t)SCAN_STRIDE * 4);
  p.Gbuf = (float*)take((size_t)8 * NCH * 4096 * 4);
  p.Hbuf = (float*)take((size_t)8 * NCH * 4096 * 4);
  p.Sst = (float*)take((size_t)8 * NCH * 4096 * 4);
  off = offB;
  p.QKVG = (u16*)take((size_t)MP * OC * 2);
  p.AO = (float*)take((size_t)3 * SCAN_STRIDE * 4);
  p.LSE = (float*)take((size_t)3 * MT * 8 * 4);
  off = (size_t)900 << 20;
  p.bar = (unsigned*)take((size_t)XCD_BAR_WORDS * 4);
#if MEGA
  static int grid_blocks = 0;
  if (!grid_blocks) {
    int dev = 0, cus = 0, per_cu = 0;
    hipGetDevice(&dev);
    hipDeviceGetAttribute(&cus, hipDeviceAttributeMultiprocessorCount, dev);
    hipOccupancyMaxActiveBlocksPerMultiprocessor(&per_cu, mega_kernel, 256, 0);
    if (per_cu > 2) per_cu = 2;
    grid_blocks = cus * per_cu;
  }
  hipMemsetAsync(p.bar, 0, (size_t)XCD_BAR_WORDS * 4, stream);
  void* args[] = {&p};
  hipError_t e = hipLaunchCooperativeKernel((void*)mega_kernel, dim3(grid_blocks), dim3(256), args, 0, stream);
  if (e != hipSuccess) fprintf(stderr, "cooperative launch failed: %s (grid %d)\n", hipGetErrorString(e), grid_blocks);
#else
  const int G = 1024;
  phase_kernel<0><<<G, 256, 0, stream>>>(p);
  phase_kernel<1><<<G, 256, 0, stream>>>(p);
  phase_kernel<2><<<G, 256, 0, stream>>>(p);
  phase_kernel<3><<<G, 256, 0, stream>>>(p);
  phase_kernel<4><<<G, 256, 0, stream>>>(p);
  phase_kernel<5><<<G, 256, 0, stream>>>(p);
  phase_kernel<6><<<G, 256, 0, stream>>>(p);
  phase_kernel<7><<<G, 256, 0, stream>>>(p);
  phase_kernel<8><<<G, 256, 0, stream>>>(p);
  phase_kernel<9><<<G, 256, 0, stream>>>(p);
  phase_kernel<10><<<G, 256, 0, stream>>>(p);
  phase_kernel<11><<<G, 256, 0, stream>>>(p);
  phase_kernel<12><<<G, 256, 0, stream>>>(p);
#endif
}
```
